# Optimizing an MI355X kernel written in HIP

```python
import math
import jax
import jax.numpy as jnp
from jax import lax
import numpy as np

D_MODEL = 1024
BATCH = 32
SEQ = 2048
DEPTH = 2
DEC_BATCH = 32
DEC_SEQ = 64
PAST_LEN = 4096

CHUNK = 64
N_A = DEPTH // 2
N_B = DEPTH - N_A
GROUP = 16
N_GROUPS = D_MODEL // GROUP
P_STATE = 64
HEAD_DIM = 64
V_DIM = 2 * HEAD_DIM
N_HEADS = D_MODEL // V_DIM
D_FF = ((8 * D_MODEL // 3 + 127) // 128) * 128
ROPE_THETA = 10000.0
Q_BLOCK = 128
ALPHA = (2 * DEPTH) ** 0.25
BETA = (8 * DEPTH) ** -0.25
LN_EPS = 1e-5
RMS_EPS = 1e-5

kernel_name = 'yoco_s5_diffattn_streaming_step'


def layer_norm(x, g, b):
    xf = x.astype(jnp.float32)
    mu = jnp.mean(xf, axis=-1, keepdims=True)
    var = jnp.mean(jnp.square(xf - mu), axis=-1, keepdims=True)
    return ((xf - mu) * lax.rsqrt(var + LN_EPS) * g + b).astype(x.dtype)


def swiglu(x, w_in, w_out):
    a, gate = jnp.split(x @ w_in, 2, axis=-1)
    return (jax.nn.silu(a) * gate) @ w_out


def rope(x, pos):
    half = HEAD_DIM // 2
    inv = ROPE_THETA ** (-jnp.arange(half, dtype=jnp.float32) / half)
    ang = pos.astype(jnp.float32)[:, None] * inv[None, :]
    cos = jnp.cos(ang)[:, None, :]
    sin = jnp.sin(ang)[:, None, :]
    xf = x.astype(jnp.float32)
    x1, x2 = xf[..., :half], xf[..., half:]
    return jnp.concatenate([x1 * cos - x2 * sin, x1 * sin + x2 * cos], axis=-1).astype(x.dtype)


def s5_discretise(a_re, a_im, log_dt, b_re, b_im):
    f32 = jnp.float32
    lam_re = jnp.minimum(a_re.astype(f32), -1e-4)
    lam_im = a_im.astype(f32)
    dt = jnp.exp(log_dt.astype(f32))[:, None]
    mag = jnp.exp(lam_re * dt)
    lb_re = mag * jnp.cos(lam_im * dt)
    lb_im = mag * jnp.sin(lam_im * dt)
    den = lam_re * lam_re + lam_im * lam_im
    n_re = lb_re - 1.0
    c_re = (n_re * lam_re + lb_im * lam_im) / den
    c_im = (lb_im * lam_re - n_re * lam_im) / den
    b_re = b_re.astype(f32)
    b_im = b_im.astype(f32)
    bb_re = c_re[..., None] * b_re - c_im[..., None] * b_im
    bb_im = c_re[..., None] * b_im + c_im[..., None] * b_re
    return lb_re, lb_im, bb_re, bb_im


def complex_affine_combine(e1, e2):
    a1r, a1i, b1r, b1i = e1
    a2r, a2i, b2r, b2i = e2
    return (a2r * a1r - a2i * a1i,
            a2r * a1i + a2i * a1r,
            a2r * b1r - a2i * b1i + b2r,
            a2r * b1i + a2i * b1r + b2i)


def s5_mixer(x, h0_re, h0_im, a_re, a_im, log_dt, b_re, b_im, c_re, c_im, d_skip, w_glu):
    B, L, _ = x.shape
    f32 = jnp.float32
    lb_re, lb_im, bb_re, bb_im = s5_discretise(a_re, a_im, log_dt, b_re, b_im)
    c_re = c_re.astype(f32)
    c_im = c_im.astype(f32)
    blk = min(CHUNK, L)
    n_blk = L // blk
    u = x.astype(f32)
    u_blocks = u.reshape(B, n_blk, blk, N_GROUPS, GROUP).transpose(1, 0, 2, 3, 4)

    def block_step(carry, u_blk):
        h_re, h_im = carry
        bu_re = jnp.einsum('gpc,btgc->btgp', bb_re, u_blk)
        bu_im = jnp.einsum('gpc,btgc->btgp', bb_im, u_blk)
        bu_re = bu_re.at[:, 0].add(lb_re * h_re - lb_im * h_im)
        bu_im = bu_im.at[:, 0].add(lb_re * h_im + lb_im * h_re)
        a_r = jnp.broadcast_to(lb_re, bu_re.shape)
        a_i = jnp.broadcast_to(lb_im, bu_im.shape)
        _, _, hs_re, hs_im = lax.associative_scan(complex_affine_combine, (a_r, a_i, bu_re, bu_im), axis=1)
        y_blk = jnp.einsum('gcp,btgp->btgc', c_re, hs_re) - jnp.einsum('gcp,btgp->btgc', c_im, hs_im)
        return (hs_re[:, -1], hs_im[:, -1]), y_blk

    (h_re, h_im), y = lax.scan(block_step, (h0_re.astype(f32), h0_im.astype(f32)), u_blocks)
    y = y.transpose(1, 0, 2, 3, 4).reshape(B, L, D_MODEL) + d_skip.astype(f32) * u
    z = jax.nn.gelu(y).astype(x.dtype)
    out, gate = jnp.split(z @ w_glu, 2, axis=-1)
    return out * jax.nn.sigmoid(gate), h_re, h_im


def shared_kv(h, pos, w_kv):
    B, L, _ = h.shape
    k, v = jnp.split(h @ w_kv, 2, axis=-1)
    k = rope(k.reshape(B, L, 2 * N_HEADS, HEAD_DIM), pos).reshape(B, L, N_HEADS, 2, HEAD_DIM)
    return k, v.reshape(B, L, N_HEADS, V_DIM)


def diff_attend(q, q_pos, segments, lam):
    scale = HEAD_DIM ** -0.5
    scores = []
    for k, _, k_pos in segments:
        s = jnp.einsum('bqhmd,bkhmd->bhmqk', q, k).astype(jnp.float32) * scale
        visible = (k_pos[None, :] // CHUNK) <= (q_pos[:, None] // CHUNK)
        scores.append(jnp.where(visible, s, -1e30))
    p = jax.nn.softmax(jnp.concatenate(scores, axis=-1), axis=-1)
    p = p[:, :, 0] - lam * p[:, :, 1]
    out = 0.0
    start = 0
    for k, v, _ in segments:
        n = k.shape[1]
        out = out + jnp.einsum('bhqk,bkhe->bqhe', p[..., start:start + n].astype(v.dtype), v)
        start += n
    return out


def diff_attention(x, pos, k_sh, v_sh, k_past, v_past, pos_past, w_q, lam_vec, subln_g, w_o, layer_idx):
    B, L, _ = x.shape
    q = rope((x @ w_q).reshape(B, L, 2 * N_HEADS, HEAD_DIM), pos).reshape(B, L, N_HEADS, 2, HEAD_DIM)
    lam_init = 0.8 - 0.6 * math.exp(-0.3 * layer_idx)
    lv = lam_vec.astype(jnp.float32)
    lam = jnp.exp(jnp.sum(lv[0] * lv[1])) - jnp.exp(jnp.sum(lv[2] * lv[3])) + lam_init
    segments = [(k_sh, v_sh, pos)]
    if k_past is not None:
        segments = [(k_past, v_past, pos_past)] + segments
    if L <= Q_BLOCK:
        o = diff_attend(q, pos, segments, lam)
    else:
        n_qb = L // Q_BLOCK
        q_blocks = q.reshape(B, n_qb, Q_BLOCK, N_HEADS, 2, HEAD_DIM).transpose(1, 0, 2, 3, 4, 5)
        pos_blocks = pos.reshape(n_qb, Q_BLOCK)
        o = lax.map(lambda qp: diff_attend(qp[0], qp[1], segments, lam), (q_blocks, pos_blocks))
        o = o.transpose(1, 0, 2, 3, 4).reshape(B, L, N_HEADS, V_DIM)
    of = o.astype(jnp.float32)
    of = of * lax.rsqrt(jnp.mean(of * of, axis=-1, keepdims=True) + RMS_EPS) * subln_g * (1.0 - lam_init)
    return of.astype(x.dtype).reshape(B, L, D_MODEL) @ w_o


def run_trunk(x, pos, h0_re, h0_im, k_past, v_past, pos_past, w):
    new_re, new_im = [], []
    k_sh = v_sh = None
    for l in range(DEPTH):
        if l == N_A:
            k_sh, v_sh = shared_kv(x, pos, w['attn_w_kv'])
        g, b = w['ln_g'][l], w['ln_b'][l]
        x = layer_norm(ALPHA * x + 0.5 * swiglu(x, w['ffn_w_in'][l, 0], w['ffn_w_out'][l, 0]), g[0], b[0])
        if l < N_A:
            y, hr, hi = s5_mixer(x, h0_re[l], h0_im[l], w['ssm_a_re'][l], w['ssm_a_im'][l], w['ssm_log_dt'][l],
                                 w['ssm_b_re'][l], w['ssm_b_im'][l], w['ssm_c_re'][l], w['ssm_c_im'][l],
                                 w['ssm_d'][l], w['ssm_w_glu'][l])
            new_re.append(hr)
            new_im.append(hi)
        else:
            j = l - N_A
            y = diff_attention(x, pos, k_sh, v_sh, k_past, v_past, pos_past, w['attn_w_q'][j], w['attn_lam'][j],
                               w['attn_subln_g'][j], w['attn_w_o'][j], l)
        x = layer_norm(ALPHA * x + y, g[1], b[1])
        x = layer_norm(ALPHA * x + 0.5 * swiglu(x, w['ffn_w_in'][l, 1], w['ffn_w_out'][l, 1]), g[2], b[2])
    return x, jnp.stack(new_re), jnp.stack(new_im), k_sh, v_sh


def setup_inputs(seed: int = 0) -> dict:
    key = jax.random.key(seed)
    ks = jax.random.split(key, 24)
    f32 = jnp.float32

    def nrm(k, shape, s):
        return jax.random.normal(k, shape, f32) * s

    D = D_MODEL
    x_prompt = nrm(ks[0], (BATCH, SEQ, D), 1.0)
    x_sample = nrm(ks[1], (DEC_BATCH, DEC_SEQ, D), 1.0)
    cache_k = nrm(ks[2], (DEC_BATCH, PAST_LEN, N_HEADS, 2, HEAD_DIM), 1.0)
    cache_v = nrm(ks[3], (DEC_BATCH, PAST_LEN, N_HEADS, V_DIM), 1.0)
    state_ssm_re = nrm(ks[4], (N_A, DEC_BATCH, N_GROUPS, P_STATE), 0.1)
    state_ssm_im = nrm(ks[5], (N_A, DEC_BATCH, N_GROUPS, P_STATE), 0.1)
    ln_g = 1.0 + nrm(ks[6], (DEPTH, 3, D), 0.01)
    ln_b = nrm(ks[7], (DEPTH, 3, D), 0.01)
    ffn_w_in = nrm(ks[8], (DEPTH, 2, D, 2 * D_FF), D ** -0.5)
    ffn_w_out = nrm(ks[9], (DEPTH, 2, D_FF, D), (D_FF ** -0.5) * BETA)
    ssm_a_re = -0.5 + nrm(ks[10], (N_A, N_GROUPS, P_STATE), 0.01)
    ssm_a_im = math.pi * jnp.arange(P_STATE, dtype=f32) + nrm(ks[11], (N_A, N_GROUPS, P_STATE), 0.01)
    ssm_log_dt = jax.random.uniform(ks[12], (N_A, N_GROUPS), f32, math.log(1e-3), math.log(1e-1))
    ssm_b_re = nrm(ks[13], (N_A, N_GROUPS, P_STATE, GROUP), (2 * GROUP) ** -0.5)
    ssm_b_im = nrm(ks[14], (N_A, N_GROUPS, P_STATE, GROUP), (2 * GROUP) ** -0.5)
    ssm_c_re = nrm(ks[15], (N_A, N_GROUPS, GROUP, P_STATE), P_STATE ** -0.5)
    ssm_c_im = nrm(ks[16], (N_A, N_GROUPS, GROUP, P_STATE), P_STATE ** -0.5)
    ssm_d = nrm(ks[17], (N_A, D), 1.0)
    glu_scale = jnp.concatenate([jnp.full((D,), BETA, f32), jnp.ones((D,), f32)])
    ssm_w_glu = nrm(ks[18], (N_A, D, 2 * D), D ** -0.5) * glu_scale
    attn_w_q = nrm(ks[19], (N_B, D, D), D ** -0.5)
    kv_scale = jnp.concatenate([jnp.ones((D,), f32), jnp.full((D,), BETA, f32)])
    attn_w_kv = nrm(ks[20], (D, 2 * D), D ** -0.5) * kv_scale
    attn_lam = nrm(ks[21], (N_B, 4, HEAD_DIM), 0.1)
    attn_subln_g = 1.0 + nrm(ks[22], (N_B, V_DIM), 0.01)
    attn_w_o = nrm(ks[23], (N_B, D, D), (D ** -0.5) * BETA)
    return {'x_prompt': x_prompt, 'x_sample': x_sample, 'cache_k': cache_k, 'cache_v': cache_v,
            'state_ssm_re': state_ssm_re, 'state_ssm_im': state_ssm_im,
            'ln_g': ln_g, 'ln_b': ln_b, 'ffn_w_in': ffn_w_in, 'ffn_w_out': ffn_w_out,
            'ssm_a_re': ssm_a_re, 'ssm_a_im': ssm_a_im, 'ssm_log_dt': ssm_log_dt,
            'ssm_b_re': ssm_b_re, 'ssm_b_im': ssm_b_im, 'ssm_c_re': ssm_c_re, 'ssm_c_im': ssm_c_im,
            'ssm_d': ssm_d, 'ssm_w_glu': ssm_w_glu,
            'attn_w_q': attn_w_q, 'attn_w_kv': attn_w_kv, 'attn_lam': attn_lam,
            'attn_subln_g': attn_subln_g, 'attn_w_o': attn_w_o}


def reference(x_prompt, x_sample, cache_k, cache_v, state_ssm_re, state_ssm_im,
              ln_g, ln_b, ffn_w_in, ffn_w_out,
              ssm_a_re, ssm_a_im, ssm_log_dt, ssm_b_re, ssm_b_im, ssm_c_re, ssm_c_im, ssm_d, ssm_w_glu,
              attn_w_q, attn_w_kv, attn_lam, attn_subln_g, attn_w_o):
    w = {'ln_g': ln_g, 'ln_b': ln_b, 'ffn_w_in': ffn_w_in, 'ffn_w_out': ffn_w_out,
         'ssm_a_re': ssm_a_re, 'ssm_a_im': ssm_a_im, 'ssm_log_dt': ssm_log_dt,
         'ssm_b_re': ssm_b_re, 'ssm_b_im': ssm_b_im, 'ssm_c_re': ssm_c_re, 'ssm_c_im': ssm_c_im,
         'ssm_d': ssm_d, 'ssm_w_glu': ssm_w_glu,
         'attn_w_q': attn_w_q, 'attn_w_kv': attn_w_kv, 'attn_lam': attn_lam,
         'attn_subln_g': attn_subln_g, 'attn_w_o': attn_w_o}
    b_p, l_p, _ = x_prompt.shape
    pos_p = jnp.arange(l_p, dtype=jnp.int32)
    h0 = jnp.zeros((N_A, b_p, N_GROUPS, P_STATE), jnp.float32)
    y_prompt, p_ssm_re, p_ssm_im, p_k, p_v = run_trunk(x_prompt, pos_p, h0, h0, None, None, None, w)
    past = cache_k.shape[1]
    pos_past = jnp.arange(past, dtype=jnp.int32)
    pos_s = past + jnp.arange(x_sample.shape[1], dtype=jnp.int32)
    y_sample, s_ssm_re, s_ssm_im, s_k, s_v = run_trunk(x_sample, pos_s, state_ssm_re, state_ssm_im,
                                                       cache_k, cache_v, pos_past, w)
    return (y_prompt, y_sample, p_ssm_re, p_ssm_im, p_k, p_v, s_ssm_re, s_ssm_im, s_k, s_v)
```

```cpp
#include <hip/hip_runtime.h>
#include <hip/hip_bf16.h>
#include <cstdio>
#include <cstdint>
#include <cmath>
#ifndef MK_ONE_LAUNCH
#define MK_ONE_LAUNCH 1
#endif
namespace pg8 {
#define PG8_LAS __attribute__((address_space(3)))
typedef unsigned short bf16_t;
typedef short bf16x8 __attribute__((ext_vector_type(8)));
typedef float f32x4 __attribute__((ext_vector_type(4)));
typedef unsigned u32x4 __attribute__((ext_vector_type(4)));
constexpr int BM = 256, BK = 64, HALF = 128, HTB = HALF * BK * 2  , STAGE_BYTES = 8 * HTB, NXCD = 8, WGM = 8;

__host__ __device__ __forceinline__ int lds_byte(int r, int c) { const int st = (r >> 4) * 2 + (c >> 5), rr = r & 15, cc = c & 31, ob = rr * 64 + cc * 2; return st * 1024 + (ob ^ (((ob >> 9) & 1) << 5)); }
__host__ __device__ __forceinline__ void stage_rc(int b, int& R, int& C) { const int st = b / 1024, sb = b % 1024, swz = sb ^ (((sb >> 9) & 1) << 5); R = (st >> 1) * 16 + swz / 64; C = (st & 1) * 32 + (swz % 64) / 2; }
__host__ __device__ __forceinline__ int perm32(int rho) { const int n = rho >> 4, i = rho & 15; return 8 * (i >> 2) + 4 * n + (i & 3); }

struct Unit { int pm, pn; };
struct Gemm { const bf16_t* A; const bf16_t* Bt; int M, N, K; };

struct StaticOrder {
    int nM, nN, nwg, G, c;
    __host__ __device__ void init(int M, int N, int G_, int c_) { nM = M / BM; nN = N / BM; nwg = nM * nN; G = G_; c = c_; }
    __host__ __device__ bool next(int i, Unit& u) const {
        const long L = (long)i * G + c; if (L >= nwg) return false;
        int wgid = (int)L; { const int q = nwg / NXCD, r = nwg % NXCD, xcd = wgid % NXCD, off = wgid / NXCD; wgid = (xcd < r ? xcd * (q + 1) : r * (q + 1) + (xcd - r) * q) + off; }
        const int nig = WGM * nN, gid = wgid / nig, fm = gid * WGM, gsz = (nM - fm) < WGM ? (nM - fm) : WGM;
        u.pm = fm + ((wgid % nig) % gsz); u.pn = (wgid % nig) / gsz; return true;
    }
    __device__ __forceinline__ void a_ready(const Unit&) const {}
    __device__ __forceinline__ void done(const Unit&) const {}
};

__device__ __forceinline__ unsigned cvt_pk_bf16(float lo, float hi) { unsigned r; asm volatile("v_cvt_pk_bf16_f32 %0, %1, %2" : "=v"(r) : "v"(lo), "v"(hi)); return r; }
typedef float f32x2 __attribute__((ext_vector_type(2)));
__device__ __forceinline__ float bf_lo(unsigned w) { return __uint_as_float(w << 16); }
__device__ __forceinline__ float bf_hi(unsigned w) { return __uint_as_float(w & 0xffff0000u); }
__device__ __forceinline__ float sigm(float a) { return __builtin_amdgcn_rcpf(1.f + __builtin_amdgcn_exp2f(-1.4426950408889634f * a)); }
constexpr float ALPHA_RES = 1.41421356237309515f;
#define PROBE_ATOM_OFF (5 * 2 * 67584)
constexpr float ST_S1 = 1048576.f, ST_S2 = 65536.f;
struct RowStat { float mean, rstd; };
__device__ __forceinline__ float ll2f(long long v) { return (float)(int)(v >> 32) * 4294967296.f + (float)(unsigned)v; }
__device__ __forceinline__ RowStat row_stat(const long long* st, int row) {
    typedef long long ll2 __attribute__((ext_vector_type(2)));
    const ll2 s = *(const ll2*)(st + 2 * (size_t)row);
    RowStat r; r.mean = ll2f(s.x) * (1.f / (ST_S1 * 1024.f)); const float ex2 = ll2f(s.y) * (1.f / (ST_S2 * 1024.f));
    r.rstd = __builtin_amdgcn_rsqf(ex2 - r.mean * r.mean + 1e-5f); return r;
}
__device__ __forceinline__ void stat_add(long long* st, int row, float ps, float pss, int fq) {
    ps += __shfl_xor(ps, 16); pss += __shfl_xor(pss, 16); ps += __shfl_xor(ps, 32); pss += __shfl_xor(pss, 32);
    if (fq == 0) {
        __hip_atomic_fetch_add(st + 2 * (size_t)row, (long long)(int)__builtin_rintf(ps * ST_S1), __ATOMIC_RELAXED, __HIP_MEMORY_SCOPE_AGENT);
        __hip_atomic_fetch_add(st + 2 * (size_t)row + 1, (long long)(int)__builtin_rintf(pss * ST_S2), __ATOMIC_RELAXED, __HIP_MEMORY_SCOPE_AGENT);
    }
#if defined(PROBE_ATOM2)
    if (fq == 0) {
        __hip_atomic_fetch_add(st + 2 * (size_t)row + PROBE_ATOM_OFF, (long long)(int)__builtin_rintf(ps * ST_S1), __ATOMIC_RELAXED, __HIP_MEMORY_SCOPE_AGENT);
        __hip_atomic_fetch_add(st + 2 * (size_t)row + 1 + PROBE_ATOM_OFF, (long long)(int)__builtin_rintf(pss * ST_S2), __ATOMIC_RELAXED, __HIP_MEMORY_SCOPE_AGENT);
    }
#endif
}
struct LnIn { const long long* st; const float* c1; const float* c2; };

template <bool LNIN> struct EpiSwiglu {
    static constexpr bool PERM = true, AFTER_DRAIN = false;
    bf16_t* H; int ldh; LnIn ln;
    __device__ __forceinline__ void operator()(const f32x4 (&acc)[2][2][4][2], const Unit& u, int wr, int wc, int fr, int fq) const {
        const int row0 = u.pm * BM + wr * 64 + fr, col0 = u.pn * HALF + wc * 32 + 8 * fq, pc0 = u.pn * BM + wc * 32 + 8 * fq;
        f32x4 c1a[2], c2a[2], c1g[2], c2g[2];
        if (LNIN) {
#pragma unroll
            for (int n = 0; n < 2; ++n) { c1a[n] = *(const f32x4*)(ln.c1 + pc0 + 4 * n); c2a[n] = *(const f32x4*)(ln.c2 + pc0 + 4 * n); c1g[n] = *(const f32x4*)(ln.c1 + pc0 + HALF + 4 * n); c2g[n] = *(const f32x4*)(ln.c2 + pc0 + HALF + 4 * n); }
        }
#pragma unroll
        for (int ai = 0; ai < 2; ++ai)
#pragma unroll
            for (int m = 0; m < 4; ++m) {
                const int row = row0 + ai * HALF + m * 16;
                RowStat rs{0.f, 1.f}; if (LNIN) rs = row_stat(ln.st, row);
                float h[8];
#pragma unroll
                for (int n = 0; n < 2; ++n)
#pragma unroll
                    for (int i = 0; i < 4; ++i) { float a = acc[ai][0][m][n][i], g = acc[ai][1][m][n][i];
                        if (LNIN) { a = rs.rstd * (a - rs.mean * c1a[n][i]) + c2a[n][i]; g = rs.rstd * (g - rs.mean * c1g[n][i]) + c2g[n][i]; }
                        h[4 * n + i] = a * sigm(a) * g; }
                u32x4 w; w.x = cvt_pk_bf16(h[0], h[1]); w.y = cvt_pk_bf16(h[2], h[3]); w.z = cvt_pk_bf16(h[4], h[5]); w.w = cvt_pk_bf16(h[6], h[7]);
                *(u32x4*)(H + (size_t)row * ldh + col0) = w;
            }
    }
};
struct LnRes { const long long* st; const float* g; const float* b; };
template <bool LNRES, bool STATS> struct EpiResid {
    static constexpr bool PERM = true, AFTER_DRAIN = false;
    const bf16_t* X; bf16_t* T; float s; LnRes lr; long long* st_out;
    __device__ __forceinline__ void operator()(const f32x4 (&acc)[2][2][4][2], const Unit& u, int wr, int wc, int fr, int fq) const {
        const int row0 = u.pm * BM + wr * 64 + fr, col0 = u.pn * BM + wc * 32 + 8 * fq;
        f32x4 gv[2][2], bv[2][2];
        if (LNRES) {
#pragma unroll
            for (int bj = 0; bj < 2; ++bj)
#pragma unroll
                for (int n = 0; n < 2; ++n) { gv[bj][n] = *(const f32x4*)(lr.g + col0 + bj * HALF + 4 * n); bv[bj][n] = *(const f32x4*)(lr.b + col0 + bj * HALF + 4 * n); }
        }
#pragma unroll
        for (int ai = 0; ai < 2; ++ai)
#pragma unroll
            for (int m = 0; m < 4; ++m) {
                const int row = row0 + ai * HALF + m * 16;
                RowStat rs{0.f, 1.f}; if (LNRES) rs = row_stat(lr.st, row);
                float ps = 0.f, pss = 0.f;
#pragma unroll
                for (int bj = 0; bj < 2; ++bj) {
                    const size_t off = (size_t)row * 1024 + col0 + bj * HALF;
                    const u32x4 xv = *(const u32x4*)(X + off);
                    float x[8] = {bf_lo(xv.x), bf_hi(xv.x), bf_lo(xv.y), bf_hi(xv.y), bf_lo(xv.z), bf_hi(xv.z), bf_lo(xv.w), bf_hi(xv.w)};
                    float t[8];
#pragma unroll
                    for (int n = 0; n < 2; ++n)
#pragma unroll
                        for (int i = 0; i < 4; ++i) { float xx = x[4 * n + i]; if (LNRES) xx = (xx - rs.mean) * rs.rstd * gv[bj][n][i] + bv[bj][n][i];
                            const float tt = ALPHA_RES * xx + s * acc[ai][bj][m][n][i]; t[4 * n + i] = tt; ps += tt; pss += tt * tt; }
                    u32x4 w; w.x = cvt_pk_bf16(t[0], t[1]); w.y = cvt_pk_bf16(t[2], t[3]); w.z = cvt_pk_bf16(t[4], t[5]); w.w = cvt_pk_bf16(t[6], t[7]);
                    *(u32x4*)(T + off) = w;
                }
                if (STATS) stat_add(st_out, row, ps, pss, fq);
            }
    }
};
struct EpiGlu {
    static constexpr bool PERM = true, AFTER_DRAIN = false;
    const bf16_t* X; bf16_t* T; LnRes lr; long long* st_out;
    __device__ __forceinline__ void operator()(const f32x4 (&acc)[2][2][4][2], const Unit& u, int wr, int wc, int fr, int fq) const {
        const int row0 = u.pm * BM + wr * 64 + fr, col0 = u.pn * HALF + wc * 32 + 8 * fq;
        f32x4 gv[2], bv[2];
#pragma unroll
        for (int n = 0; n < 2; ++n) { gv[n] = *(const f32x4*)(lr.g + col0 + 4 * n); bv[n] = *(const f32x4*)(lr.b + col0 + 4 * n); }
#pragma unroll
        for (int ai = 0; ai < 2; ++ai)
#pragma unroll
            for (int m = 0; m < 4; ++m) {
                const int row = row0 + ai * HALF + m * 16;
                const RowStat rs = row_stat(lr.st, row);
                const size_t off = (size_t)row * 1024 + col0;
                const u32x4 xv = *(const u32x4*)(X + off);
                float x[8] = {bf_lo(xv.x), bf_hi(xv.x), bf_lo(xv.y), bf_hi(xv.y), bf_lo(xv.z), bf_hi(xv.z), bf_lo(xv.w), bf_hi(xv.w)};
                float t[8], ps = 0.f, pss = 0.f;
#pragma unroll
                for (int n = 0; n < 2; ++n)
#pragma unroll
                    for (int i = 0; i < 4; ++i) { const float xx = (x[4 * n + i] - rs.mean) * rs.rstd * gv[n][i] + bv[n][i];
                        const float tt = ALPHA_RES * xx + acc[ai][0][m][n][i] * sigm(acc[ai][1][m][n][i]); t[4 * n + i] = tt; ps += tt; pss += tt * tt; }
                u32x4 w; w.x = cvt_pk_bf16(t[0], t[1]); w.y = cvt_pk_bf16(t[2], t[3]); w.z = cvt_pk_bf16(t[4], t[5]); w.w = cvt_pk_bf16(t[6], t[7]);
                *(u32x4*)(T + off) = w;
                stat_add(st_out, row, ps, pss, fq);
            }
    }
};
struct EpiQ {
    static constexpr bool PERM = true, AFTER_DRAIN = false;
    bf16_t* Q; const float* rc; const float* rs; float qscale; LnIn ln;
    __device__ __forceinline__ void operator()(const f32x4 (&acc)[2][2][4][2], const Unit& u, int wr, int wc, int fr, int fq) const {
        const int row0 = u.pm * BM + wr * 64 + fr, hh = 4 * u.pn + wc, pc0 = u.pn * BM + wc * 32 + 8 * fq;
        f32x4 c1a[2], c2a[2], c1g[2], c2g[2];
#pragma unroll
        for (int n = 0; n < 2; ++n) { c1a[n] = *(const f32x4*)(ln.c1 + pc0 + 4 * n); c2a[n] = *(const f32x4*)(ln.c2 + pc0 + 4 * n); c1g[n] = *(const f32x4*)(ln.c1 + pc0 + HALF + 4 * n); c2g[n] = *(const f32x4*)(ln.c2 + pc0 + HALF + 4 * n); }
#pragma unroll
        for (int ai = 0; ai < 2; ++ai)
#pragma unroll
            for (int m = 0; m < 4; ++m) {
                const int row = row0 + ai * HALF + m * 16;
                const int pos = row < 65536 ? (row & 2047) : 4096 + ((row - 65536) & 63);
                const RowStat st = row_stat(ln.st, row);
                float lo[8], hi[8];
#pragma unroll
                for (int n = 0; n < 2; ++n) {
                    const f32x4 c = *(const f32x4*)(rc + pos * 32 + 8 * fq + 4 * n), s = *(const f32x4*)(rs + pos * 32 + 8 * fq + 4 * n);
#pragma unroll
                    for (int i = 0; i < 4; ++i) { const float x1 = st.rstd * (acc[ai][0][m][n][i] - st.mean * c1a[n][i]) + c2a[n][i], x2 = st.rstd * (acc[ai][1][m][n][i] - st.mean * c1g[n][i]) + c2g[n][i];
                        lo[4 * n + i] = (x1 * c[i] - x2 * s[i]) * qscale; hi[4 * n + i] = (x1 * s[i] + x2 * c[i]) * qscale; }
                }
                bf16_t* dst = Q + (size_t)row * 1024 + 64 * hh + 8 * fq;
                u32x4 w; w.x = cvt_pk_bf16(lo[0], lo[1]); w.y = cvt_pk_bf16(lo[2], lo[3]); w.z = cvt_pk_bf16(lo[4], lo[5]); w.w = cvt_pk_bf16(lo[6], lo[7]);
                *(u32x4*)dst = w;
                w.x = cvt_pk_bf16(hi[0], hi[1]); w.y = cvt_pk_bf16(hi[2], hi[3]); w.z = cvt_pk_bf16(hi[4], hi[5]); w.w = cvt_pk_bf16(hi[6], hi[7]);
                *(u32x4*)(dst + 32) = w;
            }
    }
};
struct EpiKV {
    static constexpr bool PERM = true, AFTER_DRAIN = false;
    bf16_t *KBp, *VBp, *KCp, *VCp;
    float *pk, *pv, *sk, *sv;
    const float* rc; const float* rs; LnIn ln;
    __device__ __forceinline__ void operator()(const f32x4 (&acc)[2][2][4][2], const Unit& u, int wr, int wc, int fr, int fq) const {
        const int row0 = u.pm * BM + wr * 64 + fr, pc0 = u.pn * BM + wc * 32 + 8 * fq; const bool isk = u.pn < 4;
        f32x4 c1a[2], c2a[2], c1g[2], c2g[2];
#pragma unroll
        for (int n = 0; n < 2; ++n) { c1a[n] = *(const f32x4*)(ln.c1 + pc0 + 4 * n); c2a[n] = *(const f32x4*)(ln.c2 + pc0 + 4 * n); c1g[n] = *(const f32x4*)(ln.c1 + pc0 + HALF + 4 * n); c2g[n] = *(const f32x4*)(ln.c2 + pc0 + HALF + 4 * n); }
#pragma unroll
        for (int ai = 0; ai < 2; ++ai)
#pragma unroll
            for (int m = 0; m < 4; ++m) {
                const int row = row0 + ai * HALF + m * 16; const bool pr = row < 65536; const int rs_ = row - 65536;
                const int pos = pr ? (row & 2047) : 4096 + (rs_ & 63);
                const size_t brow = pr ? (size_t)row : (size_t)((rs_ >> 6) * 4160 + 4096 + (rs_ & 63));
                const size_t frow = pr ? (size_t)row : (size_t)rs_;
                const RowStat st = row_stat(ln.st, row);
                float v0[8], v1[8];
#pragma unroll
                for (int n = 0; n < 2; ++n)
#pragma unroll
                    for (int i = 0; i < 4; ++i) { v0[4 * n + i] = st.rstd * (acc[ai][0][m][n][i] - st.mean * c1a[n][i]) + c2a[n][i]; v1[4 * n + i] = st.rstd * (acc[ai][1][m][n][i] - st.mean * c1g[n][i]) + c2g[n][i]; }
                if (isk) {
                    const int hh = 4 * u.pn + wc;
                    float lo[8], hi[8];
#pragma unroll
                    for (int n = 0; n < 2; ++n) {
                        const f32x4 c = *(const f32x4*)(rc + pos * 32 + 8 * fq + 4 * n), s = *(const f32x4*)(rs + pos * 32 + 8 * fq + 4 * n);
#pragma unroll
                        for (int i = 0; i < 4; ++i) { lo[4 * n + i] = v0[4 * n + i] * c[i] - v1[4 * n + i] * s[i]; hi[4 * n + i] = v0[4 * n + i] * s[i] + v1[4 * n + i] * c[i]; }
                    }
                    bf16_t* dst = (pr ? KBp : KCp) + brow * 1024 + 64 * hh + 8 * fq;
                    u32x4 w; w.x = cvt_pk_bf16(lo[0], lo[1]); w.y = cvt_pk_bf16(lo[2], lo[3]); w.z = cvt_pk_bf16(lo[4], lo[5]); w.w = cvt_pk_bf16(lo[6], lo[7]);
                    *(u32x4*)dst = w;
                    w.x = cvt_pk_bf16(hi[0], hi[1]); w.y = cvt_pk_bf16(hi[2], hi[3]); w.z = cvt_pk_bf16(hi[4], hi[5]); w.w = cvt_pk_bf16(hi[6], hi[7]);
                    *(u32x4*)(dst + 32) = w;
                    float* fd = (pr ? pk : sk) + frow * 1024 + 64 * hh + 8 * fq;
                    *(f32x4*)fd = (f32x4){lo[0], lo[1], lo[2], lo[3]}; *(f32x4*)(fd + 4) = (f32x4){lo[4], lo[5], lo[6], lo[7]};
                    *(f32x4*)(fd + 32) = (f32x4){hi[0], hi[1], hi[2], hi[3]}; *(f32x4*)(fd + 36) = (f32x4){hi[4], hi[5], hi[6], hi[7]};
                } else {
                    const int col0 = (u.pn - 4) * BM + wc * 32 + 8 * fq;
                    u32x4 w; w.x = cvt_pk_bf16(v0[0], v0[1]); w.y = cvt_pk_bf16(v0[2], v0[3]); w.z = cvt_pk_bf16(v0[4], v0[5]); w.w = cvt_pk_bf16(v0[6], v0[7]);
                    *(u32x4*)((pr ? VBp : VCp) + brow * 1024 + col0) = w;
                    w.x = cvt_pk_bf16(v1[0], v1[1]); w.y = cvt_pk_bf16(v1[2], v1[3]); w.z = cvt_pk_bf16(v1[4], v1[5]); w.w = cvt_pk_bf16(v1[6], v1[7]);
                    *(u32x4*)((pr ? VBp : VCp) + brow * 1024 + col0 + HALF) = w;
                    float* fd = (pr ? pv : sv) + frow * 1024 + col0;
                    *(f32x4*)fd = (f32x4){v0[0], v0[1], v0[2], v0[3]}; *(f32x4*)(fd + 4) = (f32x4){v0[4], v0[5], v0[6], v0[7]};
                    *(f32x4*)(fd + HALF) = (f32x4){v1[0], v1[1], v1[2], v1[3]}; *(f32x4*)(fd + HALF + 4) = (f32x4){v1[4], v1[5], v1[6], v1[7]};
                }
            }
    }
};
template <class Epi, class Sched, bool ALIGN_EPI = false, bool SP2 = false>
__device__ __forceinline__ void gemm_phase(PG8_LAS unsigned char* lds, const Gemm g, const Sched& S, const Epi& E) {
    const int tid = threadIdx.x, wid = __builtin_amdgcn_readfirstlane(tid >> 6), lane = tid & 63, wr = wid >> 2, wc = wid & 3, fr = lane & 15, fq = lane >> 4;
    const int K = g.K, nt = K / BK;
    unsigned voffA[2], voffB[2];
#pragma unroll
    for (int i = 0; i < 2; ++i) { int R, C; stage_rc(tid * 16 + i * 8192, R, C); const int Rb = Epi::PERM ? ((R & ~31) + perm32(R & 31)) : R;
        voffA[i] = (unsigned)(R * K + C) * 2u; voffB[i] = (unsigned)(Rb * K + C) * 2u; }
    const size_t kstep = (size_t)(BK * 2);
    const size_t hstep = (size_t)HALF * K * 2;
    const size_t tstep = 2 * hstep;
    const unsigned ldsw = (unsigned)wid * 1024u;
    const int aoff = lds_byte(wr * 64 + fr, fq * 8), boff = lds_byte(wc * 32 + fr, fq * 8);
#define PG8_SA(b, h) (((b) * 2 + (h)) * HTB)
#define PG8_SB(b, h) ((4 + (b) * 2 + (h)) * HTB)
#define PG8_STAGE(bufoff, gbase, voff) do { _Pragma("unroll") for (int _i = 0; _i < 2; ++_i) \
        __builtin_amdgcn_global_load_lds((const unsigned*)((const char*)(gbase) + (voff)[_i]), (PG8_LAS unsigned*)(lds + (bufoff) + ldsw + _i * 8192), 16, 0, 0); } while (0)
#define PG8_LDA(dst, b, h) do { _Pragma("unroll") for (int m = 0; m < 4; ++m) _Pragma("unroll") for (int k = 0; k < 2; ++k) dst[m][k] = *(const PG8_LAS bf16x8*)(lds + PG8_SA(b, h) + aoff + m * 2048 + k * 1024); } while (0)
#define PG8_LDB(dst, b, h) do { _Pragma("unroll") for (int n = 0; n < 2; ++n) _Pragma("unroll") for (int k = 0; k < 2; ++k) dst[n][k] = *(const PG8_LAS bf16x8*)(lds + PG8_SB(b, h) + boff + n * 2048 + k * 1024); } while (0)
#define PG8_MMA(ai, bj, At, Bt) do { __builtin_amdgcn_s_setprio(1); _Pragma("unroll") for (int m = 0; m < 4; ++m) _Pragma("unroll") for (int n = 0; n < 2; ++n) _Pragma("unroll") for (int k = 0; k < 2; ++k) \
        acc[ai][bj][m][n] = __builtin_amdgcn_mfma_f32_16x16x32_bf16(Bt[n][k], At[m][k], acc[ai][bj][m][n], 0, 0, 0); __builtin_amdgcn_s_setprio(0); } while (0)
#define PG8_WAIT_V(n) asm volatile("s_waitcnt vmcnt(" #n ")" ::: "memory")
#define PG8_WAIT_L(n) asm volatile("s_waitcnt lgkmcnt(" #n ")" ::: "memory")
#define PG8_BAR __builtin_amdgcn_s_barrier()
#define PG8_SCHED __builtin_amdgcn_sched_barrier(0)
    Unit cur, nxt; int ui = 0;
    if (!S.next(0, cur)) return;
    f32x4 acc[2][2][4][2];
#pragma unroll
    for (int a = 0; a < 2; ++a)
#pragma unroll
        for (int b = 0; b < 2; ++b)
#pragma unroll
            for (int m = 0; m < 4; ++m)
#pragma unroll
                for (int n = 0; n < 2; ++n) acc[a][b][m][n] = (f32x4){0.f, 0.f, 0.f, 0.f};
    bf16x8 At[4][2], B0[2][2], B1[2][2];
    const char* cA = (const char*)g.A + (size_t)cur.pm * tstep; const char* cB = (const char*)g.Bt + (size_t)cur.pn * tstep;
    S.a_ready(cur);
    if constexpr (SP2) {
        PG8_STAGE(PG8_SB(0, 0), cB, voffB); PG8_STAGE(PG8_SB(0, 1), cB + hstep, voffB); PG8_STAGE(PG8_SA(0, 0), cA, voffA); PG8_STAGE(PG8_SA(0, 1), cA + hstep, voffA);
        if (wr == 1) PG8_BAR;
        PG8_WAIT_V(2); PG8_BAR;
        PG8_STAGE(PG8_SB(1, 0), cB + kstep, voffB); PG8_STAGE(PG8_SA(1, 0), cA + kstep, voffA); PG8_STAGE(PG8_SB(1, 1), cB + hstep + kstep, voffB);
        PG8_WAIT_V(6); PG8_BAR;
    } else {
        PG8_STAGE(PG8_SB(0, 0), cB, voffB); PG8_STAGE(PG8_SA(0, 0), cA, voffA); PG8_STAGE(PG8_SB(0, 1), cB + hstep, voffB); PG8_STAGE(PG8_SA(0, 1), cA + hstep, voffA);
        if (wr == 1) PG8_BAR;
        PG8_WAIT_V(4); PG8_BAR;
        PG8_STAGE(PG8_SB(1, 0), cB + kstep, voffB); PG8_STAGE(PG8_SA(1, 0), cA + kstep, voffA); PG8_STAGE(PG8_SB(1, 1), cB + hstep + kstep, voffB);
        PG8_WAIT_V(6); PG8_BAR;
    }
    for (;;) {
        const bool has_next = S.next(ui + 1, nxt);
        const char* nA = has_next ? (const char*)g.A + (size_t)nxt.pm * tstep : cA; const char* nB = has_next ? (const char*)g.Bt + (size_t)nxt.pn * tstep : cB;
        for (int t = 0; t < nt; t += 2) {
            const bool last = (t == nt - 2);
            const char* a1 = cA + (size_t)(t + 1) * kstep;
            const char* a2 = last ? nA : cA + (size_t)(t + 2) * kstep; const char* b2 = last ? nB : cB + (size_t)(t + 2) * kstep;
            const char* a3 = a2 + kstep; const char* b3 = b2 + kstep;
            if (last && has_next) S.a_ready(nxt);
            if constexpr (SP2) {
            PG8_LDB(B0, 0, 0); PG8_LDB(B1, 0, 1); PG8_SCHED; PG8_LDA(At, 0, 0); PG8_STAGE(PG8_SA(1, 1), a1 + hstep, voffA);
            PG8_WAIT_V(8); PG8_WAIT_L(0); PG8_BAR; PG8_MMA(0, 0, At, B0); PG8_MMA(0, 1, At, B1); PG8_BAR; PG8_SCHED;
            PG8_LDA(At, 0, 1); PG8_STAGE(PG8_SB(0, 0), b2, voffB); PG8_STAGE(PG8_SB(0, 1), b2 + hstep, voffB); PG8_STAGE(PG8_SA(0, 0), a2, voffA);
            PG8_WAIT_V(8); PG8_WAIT_L(0); PG8_BAR; PG8_MMA(1, 0, At, B0); PG8_MMA(1, 1, At, B1); PG8_BAR; PG8_SCHED;
            PG8_LDB(B0, 1, 0); PG8_LDB(B1, 1, 1); PG8_SCHED; PG8_LDA(At, 1, 0); PG8_STAGE(PG8_SA(0, 1), a2 + hstep, voffA);
            PG8_WAIT_V(8); PG8_WAIT_L(0); PG8_BAR; PG8_MMA(0, 0, At, B0); PG8_MMA(0, 1, At, B1); PG8_BAR; PG8_SCHED;
            PG8_LDA(At, 1, 1); PG8_STAGE(PG8_SB(1, 0), b3, voffB); PG8_STAGE(PG8_SB(1, 1), b3 + hstep, voffB); PG8_STAGE(PG8_SA(1, 0), a3, voffA);
            PG8_WAIT_V(8); PG8_WAIT_L(0); PG8_BAR; PG8_MMA(1, 0, At, B0); PG8_MMA(1, 1, At, B1); PG8_BAR; PG8_SCHED;
            } else {
            PG8_LDB(B0, 0, 0); PG8_SCHED; PG8_LDA(At, 0, 0); PG8_STAGE(PG8_SA(1, 1), a1 + hstep, voffA);
            PG8_WAIT_L(8); PG8_BAR; PG8_WAIT_L(0); PG8_MMA(0, 0, At, B0); PG8_BAR; PG8_SCHED;
            PG8_LDB(B1, 0, 1); PG8_STAGE(PG8_SB(0, 0), b2, voffB);
            PG8_BAR; PG8_WAIT_L(0); PG8_MMA(0, 1, At, B1); PG8_BAR;
            PG8_LDA(At, 0, 1); PG8_STAGE(PG8_SA(0, 0), a2, voffA);
            PG8_BAR; PG8_WAIT_L(0); PG8_MMA(1, 0, At, B0); PG8_BAR; PG8_SCHED;
            PG8_STAGE(PG8_SB(0, 1), b2 + hstep, voffB);
            PG8_WAIT_V(6); PG8_BAR; PG8_MMA(1, 1, At, B1); PG8_BAR;
            PG8_LDB(B0, 1, 0); PG8_SCHED; PG8_LDA(At, 1, 0); PG8_STAGE(PG8_SA(0, 1), a2 + hstep, voffA);
            PG8_WAIT_L(8); PG8_BAR; PG8_WAIT_L(0); PG8_MMA(0, 0, At, B0); PG8_BAR; PG8_SCHED;
            PG8_LDB(B1, 1, 1); PG8_STAGE(PG8_SB(1, 0), b3, voffB);
            PG8_BAR; PG8_WAIT_L(0); PG8_MMA(0, 1, At, B1); PG8_BAR;
            PG8_LDA(At, 1, 1); PG8_STAGE(PG8_SA(1, 0), a3, voffA);
            PG8_BAR; PG8_WAIT_L(0); PG8_MMA(1, 0, At, B0); PG8_BAR; PG8_SCHED;
            PG8_STAGE(PG8_SB(1, 1), b3 + hstep, voffB);
            PG8_WAIT_V(6); PG8_BAR; PG8_MMA(1, 1, At, B1); PG8_BAR;
            }
        }
        if constexpr (ALIGN_EPI) { if (wr == 0) PG8_BAR; }
        if constexpr (!Epi::AFTER_DRAIN) { E(acc, cur, wr, wc, fr, fq); S.done(cur); }
        if (!has_next) break;
#pragma unroll
        for (int a = 0; a < 2; ++a)
#pragma unroll
            for (int b = 0; b < 2; ++b)
#pragma unroll
                for (int m = 0; m < 4; ++m)
#pragma unroll
                    for (int n = 0; n < 2; ++n) acc[a][b][m][n] = (f32x4){0.f, 0.f, 0.f, 0.f};
        cur = nxt; cA = nA; cB = nB; ++ui;
        if constexpr (ALIGN_EPI) { if (wr == 1) PG8_BAR; }
    }
    PG8_WAIT_V(0);
    if constexpr (!ALIGN_EPI) { if (wr == 0) PG8_BAR; }
    PG8_BAR;
    if constexpr (Epi::AFTER_DRAIN) { E.fused(acc, cur, wr, wc, fr, fq, lds, wid, lane); S.done(cur); }
#undef PG8_SA
#undef PG8_SB
#undef PG8_STAGE
#undef PG8_LDA
#undef PG8_LDB
#undef PG8_MMA
#undef PG8_WAIT_V
#undef PG8_WAIT_L
#undef PG8_BAR
#undef PG8_SCHED
}
}
#ifndef PG8_SP2
#define PG8_SP2 true
#endif
namespace attn_body {
using bf16=__hip_bfloat16;
using bf16x8=__attribute__((ext_vector_type(8)))short;
using s16x4=__attribute__((ext_vector_type(4)))short;
using f32x16=__attribute__((ext_vector_type(16)))float;
using u32x4=__attribute__((ext_vector_type(4)))unsigned;
constexpr int D=64,DM=1024;
constexpr int NW=8,QBLK=32,KVBLK=64;
__device__ __forceinline__ int crow(int r,int hi){return (r&3)+8*(r>>2)+4*hi;}
#define SBAR() __builtin_amdgcn_sched_barrier(0)
constexpr int NSLOT=3, SLOTB=8192, RSLOT=2*SLOTB;
constexpr int LDS_K=0, LDS_V=NSLOT*RSLOT, LDS_WS=2*NSLOT*RSLOT, LDS_OST=LDS_WS+NW*64*4, LDS_BYTES=LDS_OST+NW*4096;
constexpr float C2=0.125f*1.4426950408889634f;
__device__ __forceinline__ void glds16(const void*gsrc,unsigned lds_dst){unsigned keep;
  asm volatile("s_mov_b32 %0, m0\n\ts_mov_b32 m0, %2\n\ts_nop 0\n\tglobal_load_lds_dwordx4 %1, off\n\ts_mov_b32 m0, %0":"=&s"(keep):"v"(gsrc),"s"(lds_dst):"memory");}
__device__ __forceinline__ void glds16s(const void*sbase,unsigned voff,unsigned lds_dst){unsigned keep;
  asm volatile("s_mov_b32 %0, m0\n\ts_mov_b32 m0, %3\n\ts_nop 4\n\tglobal_load_lds_dwordx4 %1, %2\n\ts_mov_b32 m0, %0":"=&s"(keep):"v"(voff),"s"(sbase),"s"(lds_dst):"memory");}
__device__ __forceinline__ const char* uni64(const void*p){ const unsigned long long v=(unsigned long long)p; const unsigned lo=__builtin_amdgcn_readfirstlane((unsigned)v),hi=__builtin_amdgcn_readfirstlane((unsigned)(v>>32)); return (const char*)(((unsigned long long)hi<<32)|lo); }
__device__ __forceinline__ float max3f(float a,float b,float c){float r;asm("v_max3_f32 %0, %1, %2, %3":"=v"(r):"v"(a),"v"(b),"v"(c));return r;}
__device__ __forceinline__ float max2f(float a,float b){float r;asm("v_max_f32_e32 %0, %1, %2":"=v"(r):"v"(a),"v"(b));return r;}
__device__ __forceinline__ float fadd_s(float a,float b){float r;asm("v_add_f32_e32 %0, %1, %2":"=v"(r):"v"(a),"v"(b));return r;}
__device__ __forceinline__ float fsub_s(float a,float b){float r;asm("v_sub_f32_e32 %0, %1, %2":"=v"(r):"v"(a),"v"(b));return r;}
typedef float f32x2_t __attribute__((ext_vector_type(2))); typedef __bf16 bf16x2_t __attribute__((ext_vector_type(2)));
__device__ __forceinline__ unsigned cvtpk_s(float lo,float hi){f32x2_t v={lo,hi};bf16x2_t b=__builtin_convertvector(v,bf16x2_t);return __builtin_bit_cast(unsigned,b);}
#define WAIT_BAR(N) asm volatile("s_waitcnt vmcnt(" #N ") lgkmcnt(0)\n\ts_barrier":::"memory")

__device__ __forceinline__ void qkt(f32x16&p0,f32x16&p1,const char*Kslot,const bf16x8*qr,const f32x16&negm,int r32,int hi){
  const char*kb=Kslot+hi*1024+r32*16;
  #pragma unroll
  for(int d0=0;d0<4;++d0){
    const bf16x8 b0=*reinterpret_cast<const bf16x8*>(kb+d0*2048);
    const bf16x8 b1=*reinterpret_cast<const bf16x8*>(kb+d0*2048+512);
    if(d0==0){p0=__builtin_amdgcn_mfma_f32_32x32x16_bf16(b0,qr[0],negm,0,0,0);p1=__builtin_amdgcn_mfma_f32_32x32x16_bf16(b1,qr[0],negm,0,0,0);}
    else{p0=__builtin_amdgcn_mfma_f32_32x32x16_bf16(b0,qr[d0],p0,0,0,0);p1=__builtin_amdgcn_mfma_f32_32x32x16_bf16(b1,qr[d0],p1,0,0,0);}}
}
typedef __attribute__((address_space(3))) const char* lds_cptr;
typedef short v4i16_t __attribute__((ext_vector_type(4)));
__device__ __forceinline__ void kload8(bf16x8*kf,lds_cptr kp){
  kf[0]=*(const __attribute__((address_space(3))) bf16x8*)(kp);      kf[1]=*(const __attribute__((address_space(3))) bf16x8*)(kp+512);
  kf[2]=*(const __attribute__((address_space(3))) bf16x8*)(kp+2048); kf[3]=*(const __attribute__((address_space(3))) bf16x8*)(kp+2560);
  kf[4]=*(const __attribute__((address_space(3))) bf16x8*)(kp+4096); kf[5]=*(const __attribute__((address_space(3))) bf16x8*)(kp+4608);
  kf[6]=*(const __attribute__((address_space(3))) bf16x8*)(kp+6144); kf[7]=*(const __attribute__((address_space(3))) bf16x8*)(kp+6656);
}
__device__ __forceinline__ void kload2(bf16x8*kf,lds_cptr kp,int j){ kf[2*j]=*(const __attribute__((address_space(3))) bf16x8*)(kp+j*2048); kf[2*j+1]=*(const __attribute__((address_space(3))) bf16x8*)(kp+j*2048+512); }
__device__ __forceinline__ s16x4 vtr(lds_cptr p){ return __builtin_bit_cast(s16x4,__builtin_amdgcn_ds_read_tr16_b64_v4i16((__attribute__((address_space(3))) v4i16_t*)p)); }
__device__ __forceinline__ float rowmax(const f32x16&p0,const f32x16&p1){
  float a=max3f(p0[0],p0[1],p1[0]),b=max3f(p0[2],p0[3],p1[1]);a=max3f(a,p1[2],p1[3]);
  #pragma unroll
  for(int r=4;r<16;r+=4){a=max3f(a,p0[r],p0[r+1]);b=max3f(b,p0[r+2],p0[r+3]);a=max3f(a,p1[r],p1[r+1]);b=max3f(b,p1[r+2],p1[r+3]);}
  const float m=max2f(a,b);
  auto rr=__builtin_amdgcn_permlane32_swap(__float_as_uint(m),__float_as_uint(m),false,false);
  return max2f(__uint_as_float(rr[0]),__uint_as_float(rr[1]));
}
__device__ __forceinline__ void pv(f32x16*o,int vb,bf16x8 pa0,bf16x8 pa1,bf16x8 pa2,bf16x8 pa3){
  #pragma unroll
  for(int d0=0;d0<2;++d0){s16x4 lo[4],hi[4];
    #pragma unroll
    for(int ks=0;ks<4;++ks){
      asm volatile("ds_read_b64_tr_b16 %0,%1 offset:%c2":"=&v"(lo[ks]):"v"(vb),"i"(d0*4096+ks*1024):"memory");
      asm volatile("ds_read_b64_tr_b16 %0,%1 offset:%c2":"=&v"(hi[ks]):"v"(vb),"i"(d0*4096+ks*1024+512):"memory");}
    asm volatile("s_waitcnt lgkmcnt(0)":::"memory");SBAR();
    #define PK(k) (bf16x8){lo[k][0],lo[k][1],lo[k][2],lo[k][3],hi[k][0],hi[k][1],hi[k][2],hi[k][3]}
    o[d0]=__builtin_amdgcn_mfma_f32_32x32x16_bf16(pa0,PK(0),o[d0],0,0,0);
    o[d0]=__builtin_amdgcn_mfma_f32_32x32x16_bf16(pa1,PK(1),o[d0],0,0,0);
    o[d0]=__builtin_amdgcn_mfma_f32_32x32x16_bf16(pa2,PK(2),o[d0],0,0,0);
    o[d0]=__builtin_amdgcn_mfma_f32_32x32x16_bf16(pa3,PK(3),o[d0],0,0,0);
    #undef PK
  }
}

#ifndef ATTN_STORE16
#define ATTN_STORE16(p,v) (*(u32x4*)(p)=(v))
#endif
template<int THRL> __device__ __forceinline__ void attn_unit(const bf16*Qw,const bf16*__restrict__ Kh,const bf16*__restrict__ Vh,bf16*Ow,int NTr,char*shm){
  const int tid=threadIdx.x,lane=tid&63,r32=lane&31,hi=lane>>5; const int wid=__builtin_amdgcn_readfirstlane(tid>>6);
  const int wm=wid>>2, wv=(wid>>1)&1;
  const unsigned lds0=(unsigned)(uintptr_t)shm;
  float*wsf=(float*)(shm+LDS_WS)+wid*64;
  const char*Kb=uni64(Kh); const char*Vb=uni64(Vh);
  const unsigned kvoff=(unsigned)((lane*DM+wid*8)*2);
  const unsigned vvoff=(unsigned)(((16*(wid&3)+(lane>>2))*DM+(wid>>2)*32+(lane&3)*8)*2);
  const unsigned kdst=lds0+LDS_K+wid*1024, vdst=lds0+LDS_V+wid*1024;
  const int NT=(NTr<=4)?4:((NTr+1)&~1); const int tmax=NTr-1;
  #define TCL(t) (((t)<tmax)?(t):tmax)
  #define DMA_K(t,slot) do{ const char*b_=Kb+(long)TCL(t)*(KVBLK*DM*2); glds16s(b_,kvoff,(unsigned)__builtin_amdgcn_readfirstlane(kdst+(slot))); glds16s(b_+128,kvoff,(unsigned)__builtin_amdgcn_readfirstlane(kdst+SLOTB+(slot))); }while(0)
  #define DMA_V(t,slot) do{ const char*b_=Vb+(long)TCL(t)*(KVBLK*DM*2); glds16s(b_,vvoff,(unsigned)__builtin_amdgcn_readfirstlane(vdst+(slot))); glds16s(b_+128,vvoff,(unsigned)__builtin_amdgcn_readfirstlane(vdst+SLOTB+(slot))); }while(0)
  const int vb0=(int)(lds0+LDS_V)+wv*SLOTB+((lane>>4)&1)*32+(lane&3)*8+(4*hi+((lane&15)>>2))*64;
  const char*Kbase=shm+LDS_K+wm*SLOTB; bf16x8 kf[8];
  const lds_cptr shm3=(lds_cptr)shm; const lds_cptr kp0=shm3+LDS_K+wm*SLOTB+hi*1024+r32*16; const lds_cptr vp0=shm3+LDS_V+wv*SLOTB+((lane>>4)&1)*32+(lane&3)*8+(4*hi+((lane&15)>>2))*64;
  DMA_K(0,0);DMA_V(0,0);DMA_K(1,RSLOT);
  bf16x8 qr[4];
  #pragma unroll
  for(int d0=0;d0<4;++d0)qr[d0]=*reinterpret_cast<const bf16x8*>(&Qw[(long)r32*DM+d0*16+hi*8]);
  float mhat=0.f,l_reg=0.f;f32x16 o[2];o[0]=f32x16{};o[1]=f32x16{};f32x16 negm; _Pragma("unroll") for(int r_=0;r_<16;++r_){ float z_; asm volatile("v_mov_b32 %0, 0":"=v"(z_)); negm[r_]=z_; }
  #define CMASK(P0,P1,t) do{ if((t)>=NTr){ _Pragma("unroll") for(int r_=0;r_<16;++r_){P0[r_]=-INFINITY;P1[r_]=-INFINITY;} } }while(0)
  bool resc=false;
  #define START(P0,P1) do{ const float rm=rowmax(P0,P1); resc=false; \
    { const float dl=rm; mhat=fadd_s(mhat,dl); \
      _Pragma("unroll") for(int r=0;r<16;++r){P0[r]=fsub_s(P0[r],dl);P1[r]=fsub_s(P1[r],dl);} \
      _Pragma("unroll") for(int r=0;r<16;++r)negm[r]=-mhat; asm volatile("":"+v"(negm)); } \
    _Pragma("unroll") for(int r=0;r<16;++r)P0[r]=__builtin_amdgcn_exp2f(P0[r]); }while(0)
  #define RESC() do{ if(resc){ asm volatile("s_waitcnt lgkmcnt(0)":::"memory"); \
      _Pragma("unroll") for(int d_=0;d_<2;++d_) _Pragma("unroll") for(int r=0;r<16;++r)o[d_][r]*=wsf[crow(r,hi)]; } }while(0)
  f32x16 pA0,pA1,pB0,pB1;
  int sl_prev=0,sl_cur=0,sl_next=RSLOT;
  #define ROT() do{sl_prev=sl_cur;sl_cur=sl_next;sl_next=(sl_next==(NSLOT-1)*RSLOT)?0:sl_next+RSLOT;}while(0)
  DMA_K(2,2*RSLOT);
  WAIT_BAR(6);
  qkt(pA0,pA1,Kbase,qr,negm,r32,hi);asm volatile("s_nop 15\n\ts_nop 7":"+v"(pA0),"+v"(pA1));
  START(pA0,pA1);
  _Pragma("unroll") for(int r=0;r<16;++r)pA1[r]=__builtin_amdgcn_exp2f(pA1[r]);
  WAIT_BAR(0);
  DMA_K(3,0);DMA_V(1,RSLOT);
  ROT();
  kload8(kf,kp0+sl_cur);
  WAIT_BAR(4);
  s16x4 vlo[8],vhi[8]; u32x4 pw0,pw1,pw2,pw3;
  #define PKW(P,B) cvtpk_s(P[B],P[B+1])
  #define PAF(k) __builtin_bit_cast(bf16x8,pw##k)
  #define VFR(i) (bf16x8){vlo[i][0],vlo[i][1],vlo[i][2],vlo[i][3],vhi[i][0],vhi[i][1],vhi[i][2],vhi[i][3]}
  #define PIN(x) asm volatile("":"+v"(x))
  #define MX3(a,b,c) __builtin_fmaxf(__builtin_fmaxf((a),(b)),(c))
  #define GAPA(MF,A0,A1,A2,A3,W0,W1,PW) do{ MF; sacc+=A0; sacc+=A1; sacc+=A2; sacc+=A3; PIN(sacc); W0; W1; PIN(PW); SBAR(); }while(0)
  #define EX(v) __builtin_amdgcn_exp2f(v)
  #define GAPB(MF,X,B) do{ MF; X[B]=EX(X[B]); X[B+1]=EX(X[B+1]); X[B+2]=EX(X[B+2]); X[B+3]=EX(X[B+3]); PIN(X); SBAR(); }while(0)
  #define VRD(i) do{ vlo[i]=vtr(vp_+(((i)>>2)*4096+((i)&3)*1024)); vhi[i]=vtr(vp_+(((i)>>2)*4096+((i)&3)*1024+512)); }while(0)
  #define KRD(G,j) do{ if(G){ kload2(kf,kp0+sl_next,j); SBAR(); } }while(0)
  #define STEP(C0,C1,P0,P1,t,GK,GV,GL) do{ SBAR(); \
    const lds_cptr vp_=vp0+sl_prev; \
    VRD(0); SBAR(); float sacc=(P0[0]+P0[1]); \
    GAPA(C0=__builtin_amdgcn_mfma_f32_32x32x16_bf16(kf[0],qr[0],negm,0,0,0), P0[2],P0[3],P0[4],P0[5],     pw0[0]=PKW(P0,0), pw0[1]=PKW(P0,2), pw0); \
    VRD(4); SBAR(); GAPA(C1=__builtin_amdgcn_mfma_f32_32x32x16_bf16(kf[1],qr[0],negm,0,0,0), P0[6],P0[7],P0[8],P0[9],     pw0[2]=PKW(P0,4), pw0[3]=PKW(P0,6), pw0); \
    VRD(1); SBAR(); GAPA(C0=__builtin_amdgcn_mfma_f32_32x32x16_bf16(kf[2],qr[1],C0,0,0,0),   P0[10],P0[11],P0[12],P0[13], pw1[0]=PKW(P0,8), pw1[1]=PKW(P0,10), pw1); \
    VRD(5); SBAR(); GAPA(C1=__builtin_amdgcn_mfma_f32_32x32x16_bf16(kf[3],qr[1],C1,0,0,0),   P0[14],P0[15],P1[0],P1[1],   pw1[2]=PKW(P0,12),pw1[3]=PKW(P0,14), pw1); \
    VRD(2); SBAR(); GAPA(C0=__builtin_amdgcn_mfma_f32_32x32x16_bf16(kf[4],qr[2],C0,0,0,0),   P1[2],P1[3],P1[4],P1[5],     pw2[0]=PKW(P1,0), pw2[1]=PKW(P1,2), pw2); \
    VRD(6); SBAR(); GAPA(C1=__builtin_amdgcn_mfma_f32_32x32x16_bf16(kf[5],qr[2],C1,0,0,0),   P1[6],P1[7],P1[8],P1[9],     pw2[2]=PKW(P1,4), pw2[3]=PKW(P1,6), pw2); \
    VRD(3); SBAR(); GAPA(C0=__builtin_amdgcn_mfma_f32_32x32x16_bf16(kf[6],qr[3],C0,0,0,0),   P1[10],P1[11],P1[12],P1[13], pw3[0]=PKW(P1,8), pw3[1]=PKW(P1,10), pw3); \
    VRD(7); SBAR(); GAPA(C1=__builtin_amdgcn_mfma_f32_32x32x16_bf16(kf[7],qr[3],C1,0,0,0),   P1[14],P1[15],0.f,0.f,       pw3[2]=PKW(P1,12),pw3[3]=PKW(P1,14), pw3); \
    l_reg+=sacc; \
    if(GK){DMA_K((t)+3,sl_cur);} if(GV){DMA_V((t)+1,sl_next);} \
    CMASK(C0,C1,t); \
    { float a=MX3(C0[0],C0[1],C1[0]),b=MX3(C0[2],C0[3],C1[1]); a=MX3(a,C1[2],C1[3]); \
      _Pragma("unroll") for(int r=4;r<16;r+=4){a=MX3(a,C0[r],C0[r+1]);b=MX3(b,C0[r+2],C0[r+3]);a=MX3(a,C1[r],C1[r+1]);b=MX3(b,C1[r+2],C1[r+3]);} \
      float rm=__builtin_fmaxf(a,b); { auto rr=__builtin_amdgcn_permlane32_swap(__float_as_uint(rm),__float_as_uint(rm),false,false); rm=__builtin_fmaxf(__uint_as_float(rr[0]),__uint_as_float(rr[1])); } \
      resc=false; \
      if(__builtin_expect(__any(rm>(float)THRL),0)){ const float dl=__builtin_fmaxf(rm,0.f); mhat+=dl; \
        _Pragma("unroll") for(int r=0;r<16;++r){C0[r]-=dl;C1[r]-=dl;} \
        _Pragma("unroll") for(int r=0;r<16;++r)negm[r]=-mhat; asm volatile("":"+v"(negm)); \
        const float f=__builtin_amdgcn_exp2f(-dl); l_reg*=f; if(hi==0)wsf[r32]=f; resc=true; } } \
    SBAR(); \
    GAPB(o[0]=__builtin_amdgcn_mfma_f32_32x32x16_bf16(PAF(0),VFR(0),o[0],0,0,0), C0,0); \
    GAPB(o[1]=__builtin_amdgcn_mfma_f32_32x32x16_bf16(PAF(0),VFR(4),o[1],0,0,0), C0,4); \
    KRD(GL,0); GAPB(o[0]=__builtin_amdgcn_mfma_f32_32x32x16_bf16(PAF(1),VFR(1),o[0],0,0,0), C0,8); \
    KRD(GL,1); GAPB(o[1]=__builtin_amdgcn_mfma_f32_32x32x16_bf16(PAF(1),VFR(5),o[1],0,0,0), C0,12); \
    KRD(GL,2); GAPB(o[0]=__builtin_amdgcn_mfma_f32_32x32x16_bf16(PAF(2),VFR(2),o[0],0,0,0), C1,0); \
    KRD(GL,3); GAPB(o[1]=__builtin_amdgcn_mfma_f32_32x32x16_bf16(PAF(2),VFR(6),o[1],0,0,0), C1,4); \
    GAPB(o[0]=__builtin_amdgcn_mfma_f32_32x32x16_bf16(PAF(3),VFR(3),o[0],0,0,0), C1,8); \
    GAPB(o[1]=__builtin_amdgcn_mfma_f32_32x32x16_bf16(PAF(3),VFR(7),o[1],0,0,0), C1,12); \
    }while(0)
  int t=1;
  #undef CMASK
  #define CMASK(P0,P1,t) do{}while(0)
  for(;t+5<NT;t+=2){
    STEP(pB0,pB1,pA0,pA1,t,true,true,true);     WAIT_BAR(4); RESC(); ROT();
    STEP(pA0,pA1,pB0,pB1,t+1,true,true,true);   WAIT_BAR(4); RESC(); ROT();
  }
  #undef CMASK
  #define CMASK(P0,P1,t) do{ if((t)>=NTr){ _Pragma("unroll") for(int r_=0;r_<16;++r_){P0[r_]=-INFINITY;P1[r_]=-INFINITY;} } }while(0)
  #define ENDW(tt) do{ if((tt)+3<NT){WAIT_BAR(4);} else if((tt)+2<NT){WAIT_BAR(2);} else {WAIT_BAR(0);} }while(0)
  for(;t+1<NT;t+=2){
    STEP(pB0,pB1,pA0,pA1,t,(t+3<NT),(t+1<NT),(t+1<NT));       ENDW(t);   RESC(); ROT();
    STEP(pA0,pA1,pB0,pB1,t+1,(t+4<NT),(t+2<NT),(t+2<NT));     ENDW(t+1); RESC(); ROT();
  }
  STEP(pB0,pB1,pA0,pA1,NT-1,false,false,false); RESC();
  { float sacc=pB0[0]+pB0[1]; _Pragma("unroll") for(int r=2;r<16;++r)sacc+=pB0[r]; _Pragma("unroll") for(int r=0;r<16;++r)sacc+=pB1[r]; l_reg+=sacc;
    pw0=(u32x4){PKW(pB0,0),PKW(pB0,2),PKW(pB0,4),PKW(pB0,6)};pw1=(u32x4){PKW(pB0,8),PKW(pB0,10),PKW(pB0,12),PKW(pB0,14)};pw2=(u32x4){PKW(pB1,0),PKW(pB1,2),PKW(pB1,4),PKW(pB1,6)};pw3=(u32x4){PKW(pB1,8),PKW(pB1,10),PKW(pB1,12),PKW(pB1,14)};
    SBAR(); pv(o,vb0+sl_cur,PAF(0),PAF(1),PAF(2),PAF(3)); }
  #undef PKW
  #undef PAF
  #undef VFR
  #undef PIN
  #undef MX3
  #undef GAPA
  #undef GAPB
  #undef EX
  #undef VRD
  #undef KRD
  #undef STEP
  #undef ENDW
  {auto rr=__builtin_amdgcn_permlane32_swap(__float_as_uint(l_reg),__float_as_uint(l_reg),false,false);l_reg=__uint_as_float(rr[0])+__uint_as_float(rr[1]);}
  if(hi==0)wsf[32+r32]=l_reg;asm volatile("s_waitcnt lgkmcnt(0)":::"memory");
  float rli[16];
  #pragma unroll
  for(int r=0;r<16;++r)rli[r]=__builtin_amdgcn_rcpf(wsf[32+crow(r,hi)]);
  { bf16*stg=(bf16*)(shm+LDS_OST)+wid*2048;
    #pragma unroll
    for(int r=0;r<16;++r){const int orow=crow(r,hi);
      #pragma unroll
      for(int d0=0;d0<2;++d0)stg[orow*64+d0*32+r32]=__float2bfloat16(o[d0][r]*rli[r]);}
    asm volatile("s_waitcnt lgkmcnt(0)":::"memory");
    #pragma unroll
    for(int i=0;i<4;++i){const int row=i*8+(lane>>3),ch=lane&7; const u32x4 v=*(const u32x4*)(stg+row*64+ch*8); ATTN_STORE16(Ow+(long)row*DM+ch*8,v);} }
  asm volatile("s_waitcnt lgkmcnt(0)\n\ts_barrier":::"memory");
  #undef DMA_K
  #undef DMA_V
  #undef TCL
  #undef CMASK
  #undef START
  #undef RESC
  #undef ROT
}
constexpr int ATTN_LDS_BYTES=LDS_BYTES;
#undef SBAR
#undef WAIT_BAR
}
constexpr int NWAVES = 8;
#ifndef MK_ONE_LAUNCH
#define MK_ONE_LAUNCH 1
#endif
constexpr int DMODEL = 1024, DFF = 2816, MP = 65536, MS = 2048, MT = MP + MS;
constexpr int NSTREAM_P = 32, SEQ_P = 2048, NSTREAM_S = 32, SEQ_S = 64, PAST = 4096, KCL = PAST + SEQ_S;
constexpr int NPHASE = 16;
constexpr float LN_EPSF = 1e-5f, RMS_EPSF = 1e-5f;
constexpr float LAM_INIT = 0.35550906759096924f;
constexpr size_t O_Y = 0, O_PSR = (size_t)MT * 1024, O_PSI = O_PSR + 131072, O_PK = O_PSI + 131072, O_PV = O_PK + (size_t)MP * 1024,
                 O_SSR = O_PV + (size_t)MP * 1024, O_SSI = O_SSR + 131072, O_SK = O_SSI + 131072, O_SV = O_SK + (size_t)MS * 1024, O_END = O_SV + (size_t)MS * 1024;
static_assert(O_END == 208142336ull, "output size");
constexpr size_t MiB = 1u << 20;
constexpr size_t WS_CTL = 0, CTL_ZERO_BYTES = 1 * MiB;
constexpr size_t WS_RC = 1 * MiB, WS_RS = 2 * MiB;
constexpr size_t WS_S5 = 3 * MiB;
constexpr size_t WS_WIN = 4 * MiB, WIN_BYTES = 11 * MiB;
constexpr size_t WS_WOUT = 48 * MiB, WOUT_BYTES = 5767168;
constexpr size_t WS_WGLU = 72 * MiB, WS_WQ = 76 * MiB, WS_WKV = 78 * MiB, WS_WO = 82 * MiB;
constexpr size_t WS_XB = 84 * MiB;
constexpr size_t WS_TB = WS_XB + 132 * MiB;
constexpr size_t WS_HB = WS_TB + 132 * MiB;
constexpr size_t WS_ZB = WS_HB, WS_QB = WS_HB, WS_O2 = WS_HB + 132 * MiB;
constexpr size_t WS_KB = WS_HB + 363 * MiB, WS_VB = WS_KB + 128 * MiB;
constexpr size_t WS_KC = WS_VB + 128 * MiB, WS_VC = WS_KC + 260 * MiB;
constexpr size_t WS_ST = WS_VC + 260 * MiB;
constexpr size_t WS_END = WS_ST + 12 * MiB;
constexpr size_t WS_C12LL = 65536;
constexpr size_t WS_C12F = WS_S5 + 640 * 1024;
constexpr int C_IN01 = 0, C_KV = 5632, C_IN10 = 7680, C_Q = 13312, C_IN11 = 14336, NC12 = 19968;
static_assert(WS_C12LL + 2 * NC12 * 8 <= CTL_ZERO_BYTES && (size_t)10 * MT * 16 <= 12 * MiB, "deferred LayerNorm tables");
static_assert(WS_WOUT + 4 * WOUT_BYTES <= WS_WGLU && WS_WIN + 4 * WIN_BYTES <= WS_WOUT, "weight map");
constexpr int CW_TMO = 0, CW_BAR = 4096;
constexpr int RING_BYTES = 133120;
constexpr int LDSCTL_OFF = 135168, MISC_OFF = LDSCTL_OFF + 320, LDS_BYTES = 147456;
static_assert(attn_body::ATTN_LDS_BYTES <= RING_BYTES && pg8::STAGE_BYTES <= RING_BYTES && MISC_OFF + 128 <= LDS_BYTES, "LDS map");

#define GAS __attribute__((address_space(1)))
#define LAS __attribute__((address_space(3)))
typedef unsigned short bf16;
typedef unsigned v4u __attribute__((ext_vector_type(4)));
typedef unsigned v2u __attribute__((ext_vector_type(2)));
typedef float f32x4 __attribute__((ext_vector_type(4)));
typedef GAS unsigned gu32;
#define RLX_AGENT __ATOMIC_RELAXED, __HIP_MEMORY_SCOPE_AGENT
#define LDS_WAIT() asm volatile("s_waitcnt lgkmcnt(0)" ::: "memory")
#define VM_WAIT() asm volatile("s_waitcnt vmcnt(0)" ::: "memory")
__device__ __forceinline__ unsigned f2bf(float f) { unsigned u = __builtin_bit_cast(unsigned, f); return (u + 0x7fffu + ((u >> 16) & 1u)) >> 16; }
__device__ __forceinline__ unsigned pk2(float lo, float hi) { return f2bf(lo) | (f2bf(hi) << 16); }
__device__ __forceinline__ float bflo(unsigned w) { return __uint_as_float(w << 16); }
__device__ __forceinline__ float bfhi(unsigned w) { return __uint_as_float(w & 0xffff0000u); }
__device__ __forceinline__ float wave_sum(float v) {
#pragma unroll
    for (int o = 1; o < 64; o <<= 1) v += __shfl_xor(v, o);
    return v;
}
#define XB_TMO      128
#define XB_XCNT(j)  (256  + 64 * (j))
#define XB_XSUB(j)  (1280 + 64 * (j))
#define XB_XGEN(j)  (2304 + 64 * (j))
#define XB_TOP      3328
#define XB_TOPGEN   3392
#define XCD_BAR_WORDS 3456
#define XB_SPIN_CAP (1u << 18)

__device__ __forceinline__ unsigned xb_ld(unsigned* p)              { return __hip_atomic_load(p, __ATOMIC_RELAXED, __HIP_MEMORY_SCOPE_AGENT); }
__device__ __forceinline__ unsigned xb_add(unsigned* p, unsigned v) { return __hip_atomic_fetch_add(p, v, __ATOMIC_RELAXED, __HIP_MEMORY_SCOPE_AGENT); }
__device__ __forceinline__ unsigned xb_xcc_id() { return (unsigned)__builtin_amdgcn_s_getreg((3 << 11) | 20) & 0xFu; }
#define XB_SPIN(cond, bar) do { unsigned _sp = 0; while (cond) { __builtin_amdgcn_s_sleep(1); \
    if ((++_sp & 255u) == 0u) { if (xb_ld(&(bar)[XB_TMO])) break; if (_sp > XB_SPIN_CAP) { atomicAdd(&(bar)[XB_TMO], 1u); break; } } } } while (0)

struct XcdBarrier {
    unsigned* bar; unsigned x;
    volatile LAS unsigned* st;
};

__device__ __forceinline__ XcdBarrier xcd_barrier_post(unsigned* bar, volatile LAS unsigned* st) {
    XcdBarrier b; b.bar = bar; b.x = xb_xcc_id(); b.st = st;
    if (threadIdx.x == 0) (void)xb_add(&bar[XB_XCNT(b.x)], 1u);
    return b;
}
__device__ __forceinline__ void xcd_barrier_complete(unsigned* bar, unsigned x, unsigned& nloc, unsigned& nx) {
    const unsigned G = gridDim.x * gridDim.y * gridDim.z;
    unsigned sum, cnt, mine, sp = 0u;
    for (;;) {
        sum = 0u; cnt = 0u; mine = 0u;
#pragma unroll
        for (unsigned j = 0; j < 16; ++j) { const unsigned c = xb_ld(&bar[XB_XCNT(j)]); sum += c; cnt += (c > 0u) ? 1u : 0u; mine = (j == x) ? c : mine; }
        if (sum == G) break;
        __builtin_amdgcn_s_sleep(1);
        if ((++sp & 255u) == 0u) { if (xb_ld(&bar[XB_TMO])) break; if (sp > XB_SPIN_CAP) { atomicAdd(&bar[XB_TMO], 1u); break; } }
    }
    nloc = mine > 0u ? mine : 1u; nx = cnt > 0u ? cnt : 1u;
}

__device__ __forceinline__ void xcd_barrier(const XcdBarrier& b) {
    asm volatile("s_waitcnt vmcnt(0)" ::: "memory");
    __syncthreads();
    if (threadIdx.x == 0) {
        unsigned* bar = b.bar;
        __builtin_amdgcn_s_waitcnt(0);
        unsigned nloc = b.st[0], nx = b.st[1];
        if (nloc == 0u) { xcd_barrier_complete(bar, b.x, nloc, nx); b.st[0] = nloc; b.st[1] = nx; }
        const unsigned old = xb_add(&bar[XB_XSUB(b.x)], 1u);
        const unsigned gen = old / nloc;
        if (old + 1u == (gen + 1u) * nloc) {
            __builtin_amdgcn_fence(__ATOMIC_RELEASE, "agent");
            asm volatile("s_waitcnt vmcnt(0)" ::: "memory");
            const unsigned og = xb_add(&bar[XB_TOP], 1u);
            const unsigned tg = og / nx;
            if (og + 1u == (tg + 1u) * nx) xb_add(&bar[XB_TOPGEN], 1u);
            else XB_SPIN(xb_ld(&bar[XB_TOPGEN]) == tg, bar);
            __builtin_amdgcn_fence(__ATOMIC_ACQUIRE, "agent");
            xb_add(&bar[XB_XGEN(b.x)], 1u);
            asm volatile("s_waitcnt vmcnt(0)" ::: "memory");
        } else {
            XB_SPIN(xb_ld(&bar[XB_XGEN(b.x)]) == gen, bar);
            __builtin_amdgcn_fence(__ATOMIC_ACQUIRE, "agent");
            asm volatile("s_waitcnt vmcnt(0)" ::: "memory");
        }
    }
    __syncthreads();
}
__device__ __forceinline__ void dsincos(double x, double& s, double& c) {
    const double k = __builtin_rint(x * 0.63661977236758134308);
    double r = __builtin_fma(-k, 1.57079632679489655800e+00, x); r = __builtin_fma(-k, 6.12323399573676603587e-17, r);
    const double z = r * r;
    double sp = 1.0 / 355687428096000.0;
    sp = __builtin_fma(sp, z, -1.0 / 1307674368000.0); sp = __builtin_fma(sp, z, 1.0 / 6227020800.0); sp = __builtin_fma(sp, z, -1.0 / 39916800.0); sp = __builtin_fma(sp, z, 1.0 / 362880.0);
    sp = __builtin_fma(sp, z, -1.0 / 5040.0); sp = __builtin_fma(sp, z, 1.0 / 120.0); sp = __builtin_fma(sp, z, -1.0 / 6.0); sp = __builtin_fma(sp, z, 1.0);
    const double sr = sp * r;
    double cp = -1.0 / 6402373705728000.0;
    cp = __builtin_fma(cp, z, 1.0 / 20922789888000.0); cp = __builtin_fma(cp, z, -1.0 / 87178291200.0); cp = __builtin_fma(cp, z, 1.0 / 479001600.0); cp = __builtin_fma(cp, z, -1.0 / 3628800.0);
    cp = __builtin_fma(cp, z, 1.0 / 40320.0); cp = __builtin_fma(cp, z, -1.0 / 720.0); cp = __builtin_fma(cp, z, 1.0 / 24.0); cp = __builtin_fma(cp, z, -0.5); cp = __builtin_fma(cp, z, 1.0);
    const int q = (int)((long long)k & 3);
    s = (q == 0) ? sr : (q == 1) ? cp : (q == 2) ? -sr : -cp;
    c = (q == 0) ? cp : (q == 1) ? -sr : (q == 2) ? -cp : sr;
}
__device__ __forceinline__ double dexp(double x) {
    const double n = __builtin_rint(x * 1.44269504088896338700e+00);
    double r = __builtin_fma(-n, 6.93147180369123816490e-01, x); r = __builtin_fma(-n, 1.90821492927058770002e-10, r);
    double p = 1.0 / 6227020800.0;
    p = __builtin_fma(p, r, 1.0 / 479001600.0); p = __builtin_fma(p, r, 1.0 / 39916800.0); p = __builtin_fma(p, r, 1.0 / 3628800.0); p = __builtin_fma(p, r, 1.0 / 362880.0); p = __builtin_fma(p, r, 1.0 / 40320.0);
    p = __builtin_fma(p, r, 1.0 / 5040.0); p = __builtin_fma(p, r, 1.0 / 720.0); p = __builtin_fma(p, r, 1.0 / 120.0); p = __builtin_fma(p, r, 1.0 / 24.0); p = __builtin_fma(p, r, 1.0 / 6.0);
    p = __builtin_fma(p, r, 0.5); p = __builtin_fma(p, r, 1.0); p = __builtin_fma(p, r, 1.0);
    const long long bits = ((long long)n + 1023ll) << 52;
    return p * __builtin_bit_cast(double, bits);
}

__device__ __forceinline__ int map_col(int mode, int j) {
    const int pn = j >> 8, bj = (j >> 7) & 1, jj = j & 127;
    if (mode == 1) return bj * 2816 + 128 * pn + jj;
    if (mode == 2) return bj * 1024 + 128 * pn + jj;
    if (mode == 3 || (mode == 4 && pn < 4)) return 64 * (4 * pn + (jj >> 5)) + 32 * bj + (jj & 31);
    return j;
}
__device__ __forceinline__ void p0_transpose_item(const float* W, int K, int ldw, int N, int mode, bf16* WT, LAS float* scr, int item, int lane, const float* gk, const float* bk, long long* c1, long long* c2) {
    const int nblk = N / 32, kb = item / nblk, nb = item % nblk, k0 = 64 * kb, n0 = 32 * nb, s0 = map_col(mode, n0);
    float p1 = 0.f, p2 = 0.f;
#pragma unroll 8
    for (int i = 0; i < 32; ++i) { const int kk = 2 * i + (lane >> 5); float v = W[(size_t)(k0 + kk) * ldw + s0 + (lane & 31)];
        if (gk) { p2 += v * bk[k0 + kk]; v *= gk[k0 + kk]; p1 += __uint_as_float(f2bf(v) << 16); }
        scr[kk * 33 + (lane & 31)] = v; }
    if (gk) { p1 += __shfl_xor(p1, 32); p2 += __shfl_xor(p2, 32);
        if (lane < 32) { __hip_atomic_fetch_add(c1 + n0 + lane, (long long)__builtin_rint((double)p1 * 4294967296.0), __ATOMIC_RELAXED, __HIP_MEMORY_SCOPE_AGENT);
                         __hip_atomic_fetch_add(c2 + n0 + lane, (long long)__builtin_rint((double)p2 * 4294967296.0), __ATOMIC_RELAXED, __HIP_MEMORY_SCOPE_AGENT); } }
    LDS_WAIT(); asm volatile("" ::: "memory");
    const int c = lane & 7;
#pragma unroll
    for (int j = 0; j < 4; ++j) { const int n = (lane >> 3) + 8 * j; const LAS float* s = scr + (8 * c) * 33 + n;
        v4u o; o.x = pk2(s[0 * 33], s[1 * 33]); o.y = pk2(s[2 * 33], s[3 * 33]); o.z = pk2(s[4 * 33], s[5 * 33]); o.w = pk2(s[6 * 33], s[7 * 33]);
        *(GAS v4u*)(WT + (size_t)(n0 + n) * K + k0 + 8 * c) = o; }
    LDS_WAIT(); asm volatile("" ::: "memory");
}
__device__ __forceinline__ void cvt_stream(const float* src, bf16* dst, size_t n8, size_t blk, size_t gap, size_t gt, size_t ngt) {
    for (size_t i = gt; i < n8; i += ngt) {
        const size_t e = i * 8; const f32x4 a = *(const GAS f32x4*)(src + e), b = *(const GAS f32x4*)(src + e + 4);
        v4u o; o.x = pk2(a.x, a.y); o.y = pk2(a.z, a.w); o.z = pk2(b.x, b.y); o.w = pk2(b.z, b.w);
        *(GAS v4u*)(dst + e + (gap ? (e / blk) * gap : 0)) = o;
    }
}
struct P0Args { const float *xp, *xs, *ck, *cv, *win, *wout, *wglu, *wq, *wkv, *wo, *a_re, *a_im, *log_dt, *b_re, *b_im, *ln_g, *ln_b; unsigned char* ws; };
__device__ __forceinline__ void p0_prologue(const P0Args& A, LAS unsigned char* lds, int vcu, int G, int wave, int lane) {
    LAS float* scr = (LAS float*)(lds + wave * 16384);
    const int gw = vcu * NWAVES + wave, NGW = G * NWAVES;
    unsigned char* ws = A.ws;
    constexpr int I_IN = 16 * 176, I_OUT = 44 * 32, I_GLU = 16 * 64, I_Q = 16 * 32, I_KV = 16 * 64, I_O = 16 * 32;
    constexpr int NITEMS = 4 * I_IN + 4 * I_OUT + I_GLU + I_Q + I_KV + I_O;
    long long* C1 = (long long*)(ws + WS_C12LL); long long* C2 = C1 + NC12;
    for (int it = gw; it < NITEMS; it += NGW) {
        int r = it;
        if (r < 4 * I_IN) { const int w = r / I_IN;
            const int lni = (w == 1) ? 1 : (w == 2) ? 2 : 4, co = (w == 1) ? C_IN01 : (w == 2) ? C_IN10 : C_IN11;
            p0_transpose_item(A.win + (size_t)w * 1024 * 5632, 1024, 5632, 5632, 1, (bf16*)(ws + WS_WIN + w * WIN_BYTES), scr, r % I_IN, lane, w ? A.ln_g + lni * 1024 : nullptr, A.ln_b + lni * 1024, C1 + co, C2 + co); continue; } r -= 4 * I_IN;
        if (r < 4 * I_OUT) { const int w = r / I_OUT; p0_transpose_item(A.wout + (size_t)w * 2816 * 1024, 2816, 1024, 1024, 0, (bf16*)(ws + WS_WOUT + w * WOUT_BYTES), scr, r % I_OUT, lane, nullptr, nullptr, nullptr, nullptr); continue; } r -= 4 * I_OUT;
        if (r < I_GLU) { p0_transpose_item(A.wglu, 1024, 2048, 2048, 2, (bf16*)(ws + WS_WGLU), scr, r, lane, nullptr, nullptr, nullptr, nullptr); continue; } r -= I_GLU;
        if (r < I_Q) { p0_transpose_item(A.wq, 1024, 1024, 1024, 3, (bf16*)(ws + WS_WQ), scr, r, lane, A.ln_g + 3 * 1024, A.ln_b + 3 * 1024, C1 + C_Q, C2 + C_Q); continue; } r -= I_Q;
        if (r < I_KV) { p0_transpose_item(A.wkv, 1024, 2048, 2048, 4, (bf16*)(ws + WS_WKV), scr, r, lane, A.ln_g + 2 * 1024, A.ln_b + 2 * 1024, C1 + C_KV, C2 + C_KV); continue; } r -= I_KV;
        p0_transpose_item(A.wo, 1024, 1024, 1024, 0, (bf16*)(ws + WS_WO), scr, r, lane, nullptr, nullptr, nullptr, nullptr);
    }
    const size_t gt = (size_t)gw * 64 + lane, ngt = (size_t)NGW * 64;
    for (size_t it = gt; it < (size_t)KCL * 32; it += ngt) {
        const int pos = (int)(it >> 5), i = (int)(it & 31);
        double th = 1.0; for (int k = 0; k < i; ++k) th *= 0.74989420933245582730;
        double s, c; dsincos((double)pos * th, s, c);
        ((float*)(ws + WS_RC))[it] = (float)c; ((float*)(ws + WS_RS))[it] = (float)s;
    }
    for (size_t it = gt; it < 4096; it += ngt) {
        const int g = (int)(it >> 6);
        const double lre = fmin((double)A.a_re[it], -1e-4), lim = (double)A.a_im[it], dt = dexp((double)A.log_dt[g]);
        const double mag = dexp(lre * dt); double sn, cs; dsincos(fabs(lim * dt), sn, cs); if (lim < 0.0) sn = -sn;
        const double lbr = mag * cs, lbi = mag * sn, den = lre * lre + lim * lim, nre = lbr - 1.0;
        const double cre = (nre * lre + lbi * lim) / den, cim = (lbi * lre - nre * lim) / den;
        float* lb = (float*)(ws + WS_S5); lb[2 * it] = (float)lbr; lb[2 * it + 1] = (float)lbi;
        float* bb = (float*)(ws + WS_S5) + 8192 + it * 32;
        for (int c = 0; c < 16; ++c) { const double br = A.b_re[it * 16 + c], bi = A.b_im[it * 16 + c]; bb[c] = (float)(cre * br - cim * bi); bb[16 + c] = (float)(cre * bi + cim * br); }
    }
    { v4u* stz = (v4u*)(ws + WS_ST); for (size_t it = gt; it < (size_t)10 * MT; it += ngt) stz[it] = (v4u){0u, 0u, 0u, 0u}; }
    cvt_stream(A.xp, (bf16*)(ws + WS_XB), (size_t)MP * 1024 / 8, 1, 0, gt, ngt);
    cvt_stream(A.xs, (bf16*)(ws + WS_XB) + (size_t)MP * 1024, (size_t)MS * 1024 / 8, 1, 0, gt, ngt);
    cvt_stream(A.ck, (bf16*)(ws + WS_KC), (size_t)NSTREAM_S * PAST * 1024 / 8, (size_t)PAST * 1024, (size_t)SEQ_S * 1024, gt, ngt);
    cvt_stream(A.cv, (bf16*)(ws + WS_VC), (size_t)NSTREAM_S * PAST * 1024 / 8, (size_t)PAST * 1024, (size_t)SEQ_S * 1024, gt, ngt);
}

__device__ __forceinline__ void ln_phase(const bf16* T, const float* g, const float* b, bf16* Xo, float* Yo, int gw, int NGW, int lane) {
    constexpr int RB = 4;
    float gv[16], bv[16];
#pragma unroll
    for (int j = 0; j < 2; ++j)
#pragma unroll
        for (int i = 0; i < 8; ++i) { gv[8 * j + i] = g[512 * j + 8 * lane + i]; bv[8 * j + i] = b[512 * j + 8 * lane + i]; }
    for (int rbase = gw * RB; rbase < MT; rbase += NGW * RB) {
        v4u t0[RB], t1[RB];
#pragma unroll
        for (int k = 0; k < RB; ++k) { const int row = (rbase + k < MT) ? rbase + k : MT - 1; const bf16* tp = T + (size_t)row * 1024 + 8 * lane; t0[k] = *(const GAS v4u*)tp; t1[k] = *(const GAS v4u*)(tp + 512); }
#pragma unroll
        for (int k = 0; k < RB; ++k) {
            const int row = rbase + k; if (row >= MT) break;
            float v[16];
            v[0] = bflo(t0[k].x); v[1] = bfhi(t0[k].x); v[2] = bflo(t0[k].y); v[3] = bfhi(t0[k].y); v[4] = bflo(t0[k].z); v[5] = bfhi(t0[k].z); v[6] = bflo(t0[k].w); v[7] = bfhi(t0[k].w);
            v[8] = bflo(t1[k].x); v[9] = bfhi(t1[k].x); v[10] = bflo(t1[k].y); v[11] = bfhi(t1[k].y); v[12] = bflo(t1[k].z); v[13] = bfhi(t1[k].z); v[14] = bflo(t1[k].w); v[15] = bfhi(t1[k].w);
            float s = 0.f;
#pragma unroll
            for (int i = 0; i < 16; ++i) s += v[i];
            const float mean = wave_sum(s) * (1.f / 1024.f); float s2 = 0.f;
#pragma unroll
            for (int i = 0; i < 16; ++i) { v[i] -= mean; s2 += v[i] * v[i]; }
            const float rstd = 1.f / sqrtf(wave_sum(s2) * (1.f / 1024.f) + LN_EPSF);
#pragma unroll
            for (int i = 0; i < 16; ++i) v[i] = v[i] * rstd * gv[i] + bv[i];
            if (Yo) {
                float* yp = Yo + (size_t)row * 1024 + 8 * lane;
                *(GAS f32x4*)yp = (f32x4){v[0], v[1], v[2], v[3]}; *(GAS f32x4*)(yp + 4) = (f32x4){v[4], v[5], v[6], v[7]};
                *(GAS f32x4*)(yp + 512) = (f32x4){v[8], v[9], v[10], v[11]}; *(GAS f32x4*)(yp + 516) = (f32x4){v[12], v[13], v[14], v[15]};
            } else {
                bf16* xp = Xo + (size_t)row * 1024 + 8 * lane;
                v4u o; o.x = pk2(v[0], v[1]); o.y = pk2(v[2], v[3]); o.z = pk2(v[4], v[5]); o.w = pk2(v[6], v[7]); *(GAS v4u*)xp = o;
                o.x = pk2(v[8], v[9]); o.y = pk2(v[10], v[11]); o.z = pk2(v[12], v[13]); o.w = pk2(v[14], v[15]); *(GAS v4u*)(xp + 512) = o;
            }
        }
    }
}

__device__ __forceinline__ void combine_phase(bf16* O1, const bf16* O2, const float* lamv, const float* subg, int gw, int NGW, int lane) {
    constexpr int RB = 4;
    const float lam = expf(wave_sum(lamv[lane] * lamv[64 + lane])) - expf(wave_sum(lamv[128 + lane] * lamv[192 + lane])) + LAM_INIT;
    float gs[16];
#pragma unroll
    for (int i = 0; i < 16; ++i) gs[i] = subg[(lane & 7) * 16 + i] * (1.f - LAM_INIT);
    for (int rbase = gw * RB; rbase < MT; rbase += NGW * RB) {
        v4u a0[RB], a1[RB], b0[RB], b1[RB];
#pragma unroll
        for (int k = 0; k < RB; ++k) { const int row = (rbase + k < MT) ? rbase + k : MT - 1; const bf16* p1 = O1 + (size_t)row * 1024 + 16 * lane; const bf16* p2 = O2 + (size_t)row * 1024 + 16 * lane;
            a0[k] = *(const GAS v4u*)p1; a1[k] = *(const GAS v4u*)(p1 + 8); b0[k] = *(const GAS v4u*)p2; b1[k] = *(const GAS v4u*)(p2 + 8); }
#pragma unroll
        for (int k = 0; k < RB; ++k) {
            const int row = rbase + k; if (row >= MT) break;
            float v[16];
            v[0] = bflo(a0[k].x) - lam * bflo(b0[k].x); v[1] = bfhi(a0[k].x) - lam * bfhi(b0[k].x); v[2] = bflo(a0[k].y) - lam * bflo(b0[k].y); v[3] = bfhi(a0[k].y) - lam * bfhi(b0[k].y);
            v[4] = bflo(a0[k].z) - lam * bflo(b0[k].z); v[5] = bfhi(a0[k].z) - lam * bfhi(b0[k].z); v[6] = bflo(a0[k].w) - lam * bflo(b0[k].w); v[7] = bfhi(a0[k].w) - lam * bfhi(b0[k].w);
            v[8] = bflo(a1[k].x) - lam * bflo(b1[k].x); v[9] = bfhi(a1[k].x) - lam * bfhi(b1[k].x); v[10] = bflo(a1[k].y) - lam * bflo(b1[k].y); v[11] = bfhi(a1[k].y) - lam * bfhi(b1[k].y);
            v[12] = bflo(a1[k].z) - lam * bflo(b1[k].z); v[13] = bfhi(a1[k].z) - lam * bfhi(b1[k].z); v[14] = bflo(a1[k].w) - lam * bflo(b1[k].w); v[15] = bfhi(a1[k].w) - lam * bfhi(b1[k].w);
            float ss = 0.f;
#pragma unroll
            for (int i = 0; i < 16; ++i) ss += v[i] * v[i];
            ss += __shfl_xor(ss, 1); ss += __shfl_xor(ss, 2); ss += __shfl_xor(ss, 4);
            const float r = 1.f / sqrtf(ss * (1.f / 128.f) + RMS_EPSF);
#pragma unroll
            for (int i = 0; i < 16; ++i) v[i] = v[i] * r * gs[i];
            bf16* p1 = O1 + (size_t)row * 1024 + 16 * lane;
            v4u o; o.x = pk2(v[0], v[1]); o.y = pk2(v[2], v[3]); o.z = pk2(v[4], v[5]); o.w = pk2(v[6], v[7]); *(GAS v4u*)p1 = o;
            o.x = pk2(v[8], v[9]); o.y = pk2(v[10], v[11]); o.z = pk2(v[12], v[13]); o.w = pk2(v[14], v[15]); *(GAS v4u*)(p1 + 8) = o;
        }
    }
}

__device__ __forceinline__ float gelu_tanh(float x) { const float t = 1.5957691216057308f * (x + 0.044715f * x * x * x); return x * __builtin_amdgcn_rcpf(1.f + __builtin_amdgcn_exp2f(-1.4426950408889634f * t)); }
struct S5Args { const bf16* XB; bf16* ZB; const float* s5p; const float *c_re, *c_im, *dsk, *st_re, *st_im; float* out; const long long* st; const float *lng, *lnb; };
typedef short s5_bf16x8 __attribute__((ext_vector_type(8)));
typedef float s5_f32x16 __attribute__((ext_vector_type(16)));
__device__ __forceinline__ int s5_crow(int r, int hi) { return (r & 3) + 8 * (r >> 2) + 4 * hi; }
constexpr int S5_RS = 272, S5_WAVE_LDS = 32 * S5_RS;
__device__ __forceinline__ void s5_mfma_phase(const S5Args& A, LAS unsigned char* hs, int gw, int NGW, int lane) {
    const int p32 = lane & 31, hi = lane >> 5;
    for (int pass = 0; pass < 2; ++pass)
    for (int wu = gw; wu < 2048; wu += NGW) {
        const int stream = wu >> 6, g = wu & 63, nsub = pass == 0 ? 64 : 2;
        const size_t row0 = pass == 0 ? (size_t)stream * 2048 : (size_t)MP + (size_t)stream * 64;
        s5_bf16x8 bre[2], bim[2]; float L[2][4][2]; float h[2][2];
#pragma unroll
        for (int pb = 0; pb < 2; ++pb) {
            const int gp = g * 64 + 32 * pb + p32; const float* bb = A.s5p + 8192 + gp * 32;
#pragma unroll
            for (int k = 0; k < 8; ++k) { const int c = 4 * hi + (k & 3) + 8 * (k >> 2); bre[pb][k] = (short)f2bf(bb[c]); bim[pb][k] = (short)f2bf(bb[16 + c]); }
            const float lr = A.s5p[2 * gp], li = A.s5p[2 * gp + 1];
            L[pb][0][0] = lr; L[pb][0][1] = li;
            L[pb][1][0] = lr * lr - li * li; L[pb][1][1] = 2.f * lr * li;
            L[pb][2][0] = L[pb][1][0] * lr - L[pb][1][1] * li; L[pb][2][1] = L[pb][1][0] * li + L[pb][1][1] * lr;
            L[pb][3][0] = L[pb][1][0] * L[pb][1][0] - L[pb][1][1] * L[pb][1][1]; L[pb][3][1] = 2.f * L[pb][1][0] * L[pb][1][1];
            h[pb][0] = 0.f; h[pb][1] = 0.f;
            if (pass == 1) { h[pb][0] = A.st_re[(stream * 64 + g) * 64 + 32 * pb + p32]; h[pb][1] = A.st_im[(stream * 64 + g) * 64 + 32 * pb + p32]; }
        }
        s5_bf16x8 cm[8];
#pragma unroll
        for (int kb = 0; kb < 8; ++kb)
#pragma unroll
            for (int k = 0; k < 8; ++k) { const int p = 8 * kb + 4 * hi + (k >> 1); const int ci = (g * 16 + (p32 & 15)) * 64 + p;
                const float v = (k & 1) ? -A.c_im[ci] : A.c_re[ci]; cm[kb][k] = (short)(p32 < 16 ? f2bf(v) : 0u); }
        float dk[8];
#pragma unroll
        for (int j = 0; j < 4; ++j) { dk[j] = A.dsk[g * 16 + 4 * hi + j]; dk[4 + j] = A.dsk[g * 16 + 8 + 4 * hi + j]; }
        float lg[8], lbv[8];
#pragma unroll
        for (int j = 0; j < 4; ++j) { lg[j] = A.lng[g * 16 + 4 * hi + j]; lg[4 + j] = A.lng[g * 16 + 8 + 4 * hi + j]; lbv[j] = A.lnb[g * 16 + 4 * hi + j]; lbv[4 + j] = A.lnb[g * 16 + 8 + 4 * hi + j]; }
        const bf16* up = A.XB + (row0 + p32) * 1024 + g * 16 + 4 * hi;
        const long long* sp = A.st + 2 * (row0 + p32);
        v2u u0 = *(const GAS v2u*)up, u1 = *(const GAS v2u*)(up + 8); long long s1 = sp[0], s2 = sp[1];
        LAS unsigned* hw = (LAS unsigned*)(hs + hi * 4 * S5_RS + 4 * p32);
        const LAS unsigned char* hr = hs + p32 * S5_RS + 16 * hi;
        for (int sc = 0; sc < nsub; ++sc) {
            v2u n0 = u0, n1 = u1; long long ns1 = s1, ns2 = s2;
            if (sc + 1 < nsub) { n0 = *(const GAS v2u*)(up + (size_t)(sc + 1) * 32768); n1 = *(const GAS v2u*)(up + (size_t)(sc + 1) * 32768 + 8); ns1 = sp[(size_t)(sc + 1) * 64]; ns2 = sp[(size_t)(sc + 1) * 64 + 1]; }
            {
                const float mean = pg8::ll2f(s1) * (1.f / (1048576.f * 1024.f)), ex2 = pg8::ll2f(s2) * (1.f / (65536.f * 1024.f)), rstd = __builtin_amdgcn_rsqf(ex2 - mean * mean + LN_EPSF);
                const float x0 = (bflo(u0.x) - mean) * rstd * lg[0] + lbv[0], x1 = (bfhi(u0.x) - mean) * rstd * lg[1] + lbv[1], x2 = (bflo(u0.y) - mean) * rstd * lg[2] + lbv[2], x3 = (bfhi(u0.y) - mean) * rstd * lg[3] + lbv[3];
                const float x4 = (bflo(u1.x) - mean) * rstd * lg[4] + lbv[4], x5 = (bfhi(u1.x) - mean) * rstd * lg[5] + lbv[5], x6 = (bflo(u1.y) - mean) * rstd * lg[6] + lbv[6], x7 = (bfhi(u1.y) - mean) * rstd * lg[7] + lbv[7];
                u0.x = pk2(x0, x1); u0.y = pk2(x2, x3); u1.x = pk2(x4, x5); u1.y = pk2(x6, x7);
            }
            const v4u uw = {u0.x, u0.y, u1.x, u1.y};
            const s5_bf16x8 ua = __builtin_bit_cast(s5_bf16x8, uw);
            s5_f32x16 xr[2], xi[2];
            const s5_f32x16 z16 = {};
#pragma unroll
            for (int pb = 0; pb < 2; ++pb) { xr[pb] = __builtin_amdgcn_mfma_f32_32x32x16_bf16(ua, bre[pb], z16, 0, 0, 0); xi[pb] = __builtin_amdgcn_mfma_f32_32x32x16_bf16(ua, bim[pb], z16, 0, 0, 0); }
#pragma unroll
            for (int pb = 0; pb < 2; ++pb) {
                const float l1r = L[pb][0][0], l1i = L[pb][0][1], l4r = L[pb][3][0], l4i = L[pb][3][1];
#pragma unroll
                for (int q = 0; q < 4; ++q)
#pragma unroll
                    for (int i = 1; i < 4; ++i) { const float pr = xr[pb][4 * q + i - 1], pi = xi[pb][4 * q + i - 1];
                        xr[pb][4 * q + i] += l1r * pr - l1i * pi; xi[pb][4 * q + i] += l1r * pi + l1i * pr; }
                float cr[9], ci[9]; cr[0] = h[pb][0]; ci[0] = h[pb][1];
#pragma unroll
                for (int q = 0; q < 4; ++q) {
                    const float er = xr[pb][4 * q + 3], ei = xi[pb][4 * q + 3];
                    const auto sr = __builtin_amdgcn_permlane32_swap(__float_as_uint(er), __float_as_uint(er), false, false);
                    const auto si = __builtin_amdgcn_permlane32_swap(__float_as_uint(ei), __float_as_uint(ei), false, false);
                    const float e0r = __uint_as_float(sr[0]), e1r = __uint_as_float(sr[1]), e0i = __uint_as_float(si[0]), e1i = __uint_as_float(si[1]);
                    cr[2 * q + 1] = l4r * cr[2 * q] - l4i * ci[2 * q] + e0r; ci[2 * q + 1] = l4r * ci[2 * q] + l4i * cr[2 * q] + e0i;
                    cr[2 * q + 2] = l4r * cr[2 * q + 1] - l4i * ci[2 * q + 1] + e1r; ci[2 * q + 2] = l4r * ci[2 * q + 1] + l4i * cr[2 * q + 1] + e1i;
                }
                h[pb][0] = cr[8]; h[pb][1] = ci[8];
#pragma unroll
                for (int q = 0; q < 4; ++q) { const float mr = hi ? cr[2 * q + 1] : cr[2 * q], mi = hi ? ci[2 * q + 1] : ci[2 * q];
#pragma unroll
                    for (int i = 0; i < 4; ++i) { xr[pb][4 * q + i] += L[pb][i][0] * mr - L[pb][i][1] * mi; xi[pb][4 * q + i] += L[pb][i][0] * mi + L[pb][i][1] * mr; } }
#pragma unroll
                for (int r = 0; r < 16; ++r) hw[((r & 3) + 8 * (r >> 2)) * (S5_RS / 4) + 32 * pb] = pk2(xr[pb][r], xi[pb][r]);
            }
            s5_f32x16 yt = {};
#pragma unroll
            for (int kb = 0; kb < 8; ++kb) { const s5_bf16x8 hf = *(const LAS s5_bf16x8*)(hr + 32 * kb); yt = __builtin_amdgcn_mfma_f32_32x32x16_bf16(cm[kb], hf, yt, 0, 0, 0); }
            {
                float z[8];
                z[0] = gelu_tanh(yt[0] + dk[0] * bflo(u0.x)); z[1] = gelu_tanh(yt[1] + dk[1] * bfhi(u0.x)); z[2] = gelu_tanh(yt[2] + dk[2] * bflo(u0.y)); z[3] = gelu_tanh(yt[3] + dk[3] * bfhi(u0.y));
                z[4] = gelu_tanh(yt[4] + dk[4] * bflo(u1.x)); z[5] = gelu_tanh(yt[5] + dk[5] * bfhi(u1.x)); z[6] = gelu_tanh(yt[6] + dk[6] * bflo(u1.y)); z[7] = gelu_tanh(yt[7] + dk[7] * bfhi(u1.y));
                bf16* zp = A.ZB + (row0 + (size_t)sc * 32 + p32) * 1024 + g * 16 + 4 * hi;
                v2u o; o.x = pk2(z[0], z[1]); o.y = pk2(z[2], z[3]); *(GAS v2u*)zp = o;
                o.x = pk2(z[4], z[5]); o.y = pk2(z[6], z[7]); *(GAS v2u*)(zp + 8) = o;
            }
            u0 = n0; u1 = n1; s1 = ns1; s2 = ns2;
        }
        if (hi == 0) {
            float* ore = A.out + (pass == 0 ? O_PSR : O_SSR) + (size_t)(stream * 64 + g) * 64 + p32;
            ore[0] = h[0][0]; ore[32] = h[1][0]; ore[131072] = h[0][1]; ore[131072 + 32] = h[1][1];
        }
    }
}
__device__ __forceinline__ void attention_phase(char* lds, const bf16* QB, const bf16* KB, const bf16* VB, const bf16* KC, const bf16* VC, bf16* O1, bf16* O2, int vcu, int G) {
    typedef attn_body::bf16 abf;
    const int wid = __builtin_amdgcn_readfirstlane((int)(threadIdx.x >> 6)), wm = wid >> 2, wv = (wid >> 1) & 1, qh = wid & 1;
    const int ngrp = G / 32;
    for (int grp = vcu / 32; grp < 8; grp += ngrp) {
        const int c = vcu % 32;
        for (int s = 0; s < 33; ++s) {
            const bool smp = (s == c); const int i = s - (s > c ? 1 : 0);
            const int bh = grp * 32 + (smp ? c : i), b = bh >> 3, h = bh & 7, j = (i & 1) ? 31 - c : c;
            const size_t qrow = smp ? (size_t)MP + (size_t)b * SEQ_S + 32 * qh : (size_t)b * SEQ_P + 64 * j + 32 * qh;
            const size_t krow = smp ? (size_t)b * KCL : (size_t)b * SEQ_P;
            const bf16* Kh = (smp ? KC : KB) + krow * 1024 + h * 128; const bf16* Vh = (smp ? VC : VB) + krow * 1024 + h * 128;
            attn_body::attn_unit<8>((const abf*)(QB + qrow * 1024 + h * 128 + wm * 64), (const abf*)Kh, (const abf*)Vh, (abf*)((wm ? O2 : O1) + qrow * 1024 + h * 128 + wv * 64), smp ? KCL / 64 : j + 1, lds);
        }
    }
}

struct Args { const float* in[24]; float* out; unsigned char* ws; int ph_lo, ph_hi, li, pad; };
__global__ void __launch_bounds__(NWAVES * 64, 2) yoco_fwd(Args args) {
    extern __shared__ __attribute__((aligned(16))) unsigned char lds[];
    LAS unsigned char* const L = (LAS unsigned char*)lds;
    volatile LAS unsigned* MISC = (volatile LAS unsigned*)(L + MISC_OFF);
    const int tid = threadIdx.x, lane = tid & 63, wave = __builtin_amdgcn_readfirstlane(tid >> 6);
    const int G = gridDim.x; const int bx = blockIdx.x; const int vcu = (G % 8 == 0) ? (bx % 8) * (G / 8) + bx / 8 : bx;
    const int gw = vcu * NWAVES + wave, NGW = G * NWAVES;
    unsigned char* ws = args.ws;
    gu32* ctl = (gu32*)(ws + WS_CTL);
    for (int u = tid; u < (LDS_BYTES - LDSCTL_OFF) / 4; u += NWAVES * 64) ((LAS unsigned*)(L + LDSCTL_OFF))[u] = 0u;
    __syncthreads();
    XcdBarrier bar; bar.bar = (unsigned*)(ctl + CW_BAR); bar.x = 0; bar.st = nullptr;
#if MK_ONE_LAUNCH
    bar = xcd_barrier_post((unsigned*)(ctl + CW_BAR), MISC + 8);
#endif
    const int lo = args.ph_lo, hi = args.ph_hi;
#ifndef PHMASK
#define PHMASK 0xffffffffu
#endif
#define IN(k) (((PHMASK >> (k)) & 1u) && lo <= (k) && (k) < hi)
#define SEAM(k) do { if (IN(k) && IN((k) + 1)) xcd_barrier(bar); } while (0)
    const float *x_prompt = args.in[0], *x_sample = args.in[1], *cache_k = args.in[2], *cache_v = args.in[3], *st_re = args.in[4], *st_im = args.in[5], *ln_g = args.in[6], *ln_b = args.in[7],
                *ffn_w_in = args.in[8], *ffn_w_out = args.in[9], *a_re = args.in[10], *a_im = args.in[11], *log_dt = args.in[12], *b_re = args.in[13], *b_im = args.in[14], *c_re = args.in[15],
                *c_im = args.in[16], *ssm_d = args.in[17], *w_glu = args.in[18], *w_q = args.in[19], *w_kv = args.in[20], *attn_lam = args.in[21], *subln_g = args.in[22], *w_o = args.in[23];
    float* out = args.out;
    bf16* XB = (bf16*)(ws + WS_XB); bf16* TB = (bf16*)(ws + WS_TB); bf16* HB = (bf16*)(ws + WS_HB); bf16* ZB = (bf16*)(ws + WS_ZB); bf16* QB = (bf16*)(ws + WS_QB); bf16* O2 = (bf16*)(ws + WS_O2);
    bf16* KB = (bf16*)(ws + WS_KB); bf16* VB = (bf16*)(ws + WS_VB); bf16* KC = (bf16*)(ws + WS_KC); bf16* VC = (bf16*)(ws + WS_VC);
    const float* RC = (const float*)(ws + WS_RC); const float* RS = (const float*)(ws + WS_RS);
#define WIN(i) ((const bf16*)(ws + WS_WIN + (size_t)(i) * WIN_BYTES))
#define WOUT(i) ((const bf16*)(ws + WS_WOUT + (size_t)(i) * WOUT_BYTES))
    long long* ST = (long long*)(ws + WS_ST);
#define STK(k) (ST + (size_t)(k) * 2 * MT)
    const float* C1F = (const float*)(ws + WS_C12F); const float* C2F = C1F + NC12;
#define LNIN(k, co) pg8::LnIn{STK(k), C1F + (co), C2F + (co)}
#define LNRES(k) pg8::LnRes{STK(k), ln_g + (k) * 1024, ln_b + (k) * 1024}
#define FFN_UP(i, Tin, LNF, lnin) do { pg8::Gemm g{Tin, WIN(i), MT, 2 * DFF, DMODEL}; pg8::StaticOrder S; S.init(MT, 2 * DFF, G, bx); pg8::EpiSwiglu<LNF> E{HB, DFF, lnin}; \
        pg8::gemm_phase<pg8::EpiSwiglu<LNF>, pg8::StaticOrder, true, true>(L, g, S, E); } while (0)
#define FFN_DOWN(i, Tin, Tout, LNR, lnres, STATS, stout) do { pg8::Gemm g{HB, WOUT(i), MT, DMODEL, DFF}; pg8::StaticOrder S; S.init(MT, DMODEL, G, bx); pg8::EpiResid<LNR, STATS> E{Tin, Tout, 0.5f, lnres, stout}; \
        pg8::gemm_phase<pg8::EpiResid<LNR, STATS>, pg8::StaticOrder, true, true>(L, g, S, E); } while (0)
    const pg8::LnIn noin{nullptr, nullptr, nullptr}; const pg8::LnRes nores{nullptr, nullptr, nullptr};

    if (IN(0)) { P0Args A{x_prompt, x_sample, cache_k, cache_v, ffn_w_in, ffn_w_out, w_glu, w_q, w_kv, w_o, a_re, a_im, log_dt, b_re, b_im, ln_g, ln_b, ws}; p0_prologue(A, L, vcu, G, wave, lane);
#if defined(PROBE_PRO2)
        __syncthreads(); p0_prologue(A, L, vcu, G, wave, lane);
#endif
    } SEAM(0);
    if (IN(1)) {
        {
            const long long* cl = (const long long*)(ws + WS_C12LL); float* cf = (float*)(ws + WS_C12F);
            for (int i = gw * 64 + lane; i < 2 * NC12; i += NGW * 64) cf[i] = (float)((double)cl[i] * (1.0 / 4294967296.0));
        }
        FFN_UP(0, XB, false, noin);
#if defined(PROBE_UP2)
        FFN_UP(0, XB, false, noin);
#endif
    } SEAM(1);
    if (IN(2)) { FFN_DOWN(0, XB, TB, false, nores, true, STK(0)); } SEAM(2);
    if (IN(3)) { S5Args A{TB, ZB, (const float*)(ws + WS_S5), c_re, c_im, ssm_d, st_re, st_im, out, STK(0), ln_g, ln_b};
                 s5_mfma_phase(A, L + wave * S5_WAVE_LDS, gw, NGW, lane);
#if defined(PROBE_S52)
                 s5_mfma_phase(A, L + wave * S5_WAVE_LDS, gw, NGW, lane);
#endif
    } SEAM(3);
    if (IN(4)) { pg8::Gemm g{ZB, (const bf16*)(ws + WS_WGLU), MT, 2048, DMODEL}; pg8::StaticOrder S; S.init(MT, 2048, G, bx); pg8::EpiGlu E{TB, XB, LNRES(0), STK(1)};
                 pg8::gemm_phase<pg8::EpiGlu, pg8::StaticOrder, true, true>(L, g, S, E); } SEAM(4);
    if (IN(5)) { FFN_UP(1, XB, true, LNIN(1, C_IN01));
#if defined(PROBE_UP2B)
        FFN_UP(1, XB, true, LNIN(1, C_IN01));
#endif
    } SEAM(5);
    if (IN(6)) { FFN_DOWN(1, XB, TB, true, LNRES(1), true, STK(2)); } SEAM(6);
    if (IN(7)) { { pg8::Gemm g{TB, (const bf16*)(ws + WS_WKV), MT, 2048, DMODEL}; pg8::StaticOrder S; S.init(MT, 2048, G, bx);
                   pg8::EpiKV E{KB, VB, KC, VC, out + O_PK, out + O_PV, out + O_SK, out + O_SV, RC, RS, LNIN(2, C_KV)};
                   pg8::gemm_phase<pg8::EpiKV, pg8::StaticOrder, true, true>(L, g, S, E); }
                 FFN_UP(2, TB, true, LNIN(2, C_IN10)); } SEAM(7);
    if (IN(8)) { FFN_DOWN(2, TB, XB, true, LNRES(2), true, STK(3)); } SEAM(8);
    if (IN(9)) { pg8::Gemm g{XB, (const bf16*)(ws + WS_WQ), MT, DMODEL, DMODEL}; pg8::StaticOrder S; S.init(MT, DMODEL, G, bx); pg8::EpiQ E{QB, RC, RS, attn_body::C2, LNIN(3, C_Q)};
                 pg8::gemm_phase<pg8::EpiQ, pg8::StaticOrder, true, true>(L, g, S, E); } SEAM(9);
    if (IN(10)) {
#if defined(PROBE_ATTN2)
        attention_phase((char*)lds, QB, KB, VB, KC, VC, TB, TB, vcu, G);
#endif
        attention_phase((char*)lds, QB, KB, VB, KC, VC, QB, O2, vcu, G); } SEAM(10);
    if (IN(11)) { combine_phase(QB, O2, attn_lam, subln_g, gw, NGW, lane); } SEAM(11);
    if (IN(12)) { pg8::Gemm g{QB, (const bf16*)(ws + WS_WO), MT, DMODEL, DMODEL}; pg8::StaticOrder S; S.init(MT, DMODEL, G, bx); pg8::EpiResid<true, true> E{XB, TB, 1.0f, LNRES(3), STK(4)};
                  pg8::gemm_phase<pg8::EpiResid<true, true>, pg8::StaticOrder, true, true>(L, g, S, E); } SEAM(12);
    if (IN(13)) { FFN_UP(3, TB, true, LNIN(4, C_IN11)); } SEAM(13);
    if (IN(14)) { FFN_DOWN(3, TB, XB, true, LNRES(4), false, (long long*)nullptr); } SEAM(14);
    if (IN(15)) { ln_phase(XB, ln_g + 5 * 1024, ln_b + 5 * 1024, nullptr, out + O_Y, gw, NGW, lane); }
#undef IN
#undef SEAM
}

extern "C" void kernel_launch(void* const* d_in, const int* in_sizes, int n_in, void* d_out, int out_size, void* d_ws, size_t ws_size, hipStream_t stream) {
    static int grid = 0;
    if (grid == 0) {
        if (n_in != 24 || (size_t)out_size != O_END || ws_size < WS_END) { fprintf(stderr, "kernel_launch: unexpected problem shape (n_in %d, out %d, ws %zu < %zu); nothing launched\n", n_in, out_size, ws_size, (size_t)WS_END); grid = -1; return; }
        int dev = 0, cus = 0, per_cu = 0;
        if (hipGetDevice(&dev) != hipSuccess || hipDeviceGetAttribute(&cus, hipDeviceAttributeMultiprocessorCount, dev) != hipSuccess) { grid = -1; return; }
        if (hipFuncSetAttribute((const void*)yoco_fwd, hipFuncAttributeMaxDynamicSharedMemorySize, LDS_BYTES) != hipSuccess) { fprintf(stderr, "kernel_launch: hipFuncSetAttribute failed\n"); grid = -1; return; }
        if (hipOccupancyMaxActiveBlocksPerMultiprocessor(&per_cu, (const void*)yoco_fwd, NWAVES * 64, LDS_BYTES) != hipSuccess || per_cu < 1) { fprintf(stderr, "kernel_launch: occupancy query reports %d blocks per CU\n", per_cu); }
        (void)hipGetLastError();
        grid = (cus / 32) * 32; if (grid < 32) grid = 32;
    }
    if (grid < 0) return;
    if (hipMemsetAsync((char*)d_ws + WS_CTL, 0, CTL_ZERO_BYTES, stream) != hipSuccess) return;
    Args a{};
    for (int i = 0; i < 24; ++i) a.in[i] = (const float*)d_in[i];
    a.out = (float*)d_out; a.ws = (unsigned char*)d_ws; a.pad = 0;
#if MK_ONE_LAUNCH
    a.ph_lo = 0; a.ph_hi = NPHASE; a.li = 0;
    hipLaunchKernelGGL(yoco_fwd, dim3(grid), dim3(NWAVES * 64), LDS_BYTES, stream, a);
#else
    for (int p = 0; p < NPHASE; ++p) { a.ph_lo = p; a.ph_hi = p + 1; a.li = p; hipLaunchKernelGGL(yoco_fwd, dim3(grid), dim3(NWAVES * 64), LDS_BYTES, stream, a); }
#endif
}
```

```cpp
#include <hip/hip_runtime.h>
#include <hip/hip_bf16.h>
#include <cstdio>
#include <cstdint>
#include <cmath>
#ifndef MK_ONE_LAUNCH
#define MK_ONE_LAUNCH 1
#endif
namespace pg8 {
#define PG8_LAS __attribute__((address_space(3)))
typedef unsigned short bf16_t;
typedef short bf16x8 __attribute__((ext_vector_type(8)));
typedef float f32x4 __attribute__((ext_vector_type(4)));
typedef unsigned u32x4 __attribute__((ext_vector_type(4)));
constexpr int BM = 256, BK = 64, HALF = 128, HTB = HALF * BK * 2  , STAGE_BYTES = 8 * HTB, NXCD = 8, WGM = 8;

__host__ __device__ __forceinline__ int lds_byte(int r, int c) { const int st = (r >> 4) * 2 + (c >> 5), rr = r & 15, cc = c & 31, ob = rr * 64 + cc * 2; return st * 1024 + (ob ^ (((ob >> 9) & 1) << 5)); }
__host__ __device__ __forceinline__ void stage_rc(int b, int& R, int& C) { const int st = b / 1024, sb = b % 1024, swz = sb ^ (((sb >> 9) & 1) << 5); R = (st >> 1) * 16 + swz / 64; C = (st & 1) * 32 + (swz % 64) / 2; }
__host__ __device__ __forceinline__ int perm32(int rho) { const int n = rho >> 4, i = rho & 15; return 8 * (i >> 2) + 4 * n + (i & 3); }

struct Unit { int pm, pn; };
struct Gemm { const bf16_t* A; const bf16_t* Bt; int M, N, K; };

struct StaticOrder {
    int nM, nN, nwg, G, c;
    __host__ __device__ void init(int M, int N, int G_, int c_) { nM = M / BM; nN = N / BM; nwg = nM * nN; G = G_; c = c_; }
    __host__ __device__ bool next(int i, Unit& u) const {
        const long L = (long)i * G + c; if (L >= nwg) return false;
        int wgid = (int)L; { const int q = nwg / NXCD, r = nwg % NXCD, xcd = wgid % NXCD, off = wgid / NXCD; wgid = (xcd < r ? xcd * (q + 1) : r * (q + 1) + (xcd - r) * q) + off; }
        const int nig = WGM * nN, gid = wgid / nig, fm = gid * WGM, gsz = (nM - fm) < WGM ? (nM - fm) : WGM;
        u.pm = fm + ((wgid % nig) % gsz); u.pn = (wgid % nig) / gsz; return true;
    }
    __device__ __forceinline__ void a_ready(const Unit&) const {}
    __device__ __forceinline__ void done(const Unit&) const {}
};

__device__ __forceinline__ unsigned cvt_pk_bf16(float lo, float hi) { unsigned r; asm volatile("v_cvt_pk_bf16_f32 %0, %1, %2" : "=v"(r) : "v"(lo), "v"(hi)); return r; }
typedef float f32x2 __attribute__((ext_vector_type(2)));
__device__ __forceinline__ float bf_lo(unsigned w) { return __uint_as_float(w << 16); }
__device__ __forceinline__ float bf_hi(unsigned w) { return __uint_as_float(w & 0xffff0000u); }
__device__ __forceinline__ float sigm(float a) { return __builtin_amdgcn_rcpf(1.f + __builtin_amdgcn_exp2f(-1.4426950408889634f * a)); }
constexpr float ALPHA_RES = 1.41421356237309515f;

struct EpiSwiglu {
    static constexpr bool PERM = true, AFTER_DRAIN = false;
    bf16_t* H; int ldh;
    __device__ __forceinline__ void operator()(const f32x4 (&acc)[2][2][4][2], const Unit& u, int wr, int wc, int fr, int fq) const {
        const int row0 = u.pm * BM + wr * 64 + fr, col0 = u.pn * HALF + wc * 32 + 8 * fq;
#pragma unroll
        for (int ai = 0; ai < 2; ++ai)
#pragma unroll
            for (int m = 0; m < 4; ++m) {
                float h[8];
#pragma unroll
                for (int n = 0; n < 2; ++n)
#pragma unroll
                    for (int i = 0; i < 4; ++i) { const float a = acc[ai][0][m][n][i], g = acc[ai][1][m][n][i]; h[4 * n + i] = a * sigm(a) * g; }
                u32x4 w; w.x = cvt_pk_bf16(h[0], h[1]); w.y = cvt_pk_bf16(h[2], h[3]); w.z = cvt_pk_bf16(h[4], h[5]); w.w = cvt_pk_bf16(h[6], h[7]);
                *(u32x4*)(H + (size_t)(row0 + ai * HALF + m * 16) * ldh + col0) = w;
            }
    }
};
struct EpiResid {
    static constexpr bool PERM = true, AFTER_DRAIN = false;
    const bf16_t* X; bf16_t* T; float s;
    __device__ __forceinline__ void operator()(const f32x4 (&acc)[2][2][4][2], const Unit& u, int wr, int wc, int fr, int fq) const {
        const int row0 = u.pm * BM + wr * 64 + fr, col0 = u.pn * BM + wc * 32 + 8 * fq;
#pragma unroll
        for (int ai = 0; ai < 2; ++ai)
#pragma unroll
            for (int m = 0; m < 4; ++m)
#pragma unroll
                for (int bj = 0; bj < 2; ++bj) {
                    const size_t off = (size_t)(row0 + ai * HALF + m * 16) * 1024 + col0 + bj * HALF;
                    const u32x4 xv = *(const u32x4*)(X + off); const f32x4 a0 = acc[ai][bj][m][0], a1 = acc[ai][bj][m][1];
                    u32x4 w;
                    w.x = cvt_pk_bf16(ALPHA_RES * bf_lo(xv.x) + s * a0[0], ALPHA_RES * bf_hi(xv.x) + s * a0[1]);
                    w.y = cvt_pk_bf16(ALPHA_RES * bf_lo(xv.y) + s * a0[2], ALPHA_RES * bf_hi(xv.y) + s * a0[3]);
                    w.z = cvt_pk_bf16(ALPHA_RES * bf_lo(xv.z) + s * a1[0], ALPHA_RES * bf_hi(xv.z) + s * a1[1]);
                    w.w = cvt_pk_bf16(ALPHA_RES * bf_lo(xv.w) + s * a1[2], ALPHA_RES * bf_hi(xv.w) + s * a1[3]);
                    *(u32x4*)(T + off) = w;
                }
    }
};
struct EpiGlu {
    static constexpr bool PERM = true, AFTER_DRAIN = false;
    const bf16_t* X; bf16_t* T;
    __device__ __forceinline__ void operator()(const f32x4 (&acc)[2][2][4][2], const Unit& u, int wr, int wc, int fr, int fq) const {
        const int row0 = u.pm * BM + wr * 64 + fr, col0 = u.pn * HALF + wc * 32 + 8 * fq;
#pragma unroll
        for (int ai = 0; ai < 2; ++ai)
#pragma unroll
            for (int m = 0; m < 4; ++m) {
                const size_t off = (size_t)(row0 + ai * HALF + m * 16) * 1024 + col0;
                const u32x4 xv = *(const u32x4*)(X + off);
                const f32x4 o0 = acc[ai][0][m][0], o1 = acc[ai][0][m][1], g0 = acc[ai][1][m][0], g1 = acc[ai][1][m][1];
                u32x4 w;
                w.x = cvt_pk_bf16(ALPHA_RES * bf_lo(xv.x) + o0[0] * sigm(g0[0]), ALPHA_RES * bf_hi(xv.x) + o0[1] * sigm(g0[1]));
                w.y = cvt_pk_bf16(ALPHA_RES * bf_lo(xv.y) + o0[2] * sigm(g0[2]), ALPHA_RES * bf_hi(xv.y) + o0[3] * sigm(g0[3]));
                w.z = cvt_pk_bf16(ALPHA_RES * bf_lo(xv.z) + o1[0] * sigm(g1[0]), ALPHA_RES * bf_hi(xv.z) + o1[1] * sigm(g1[1]));
                w.w = cvt_pk_bf16(ALPHA_RES * bf_lo(xv.w) + o1[2] * sigm(g1[2]), ALPHA_RES * bf_hi(xv.w) + o1[3] * sigm(g1[3]));
                *(u32x4*)(T + off) = w;
            }
    }
};
struct EpiQ {
    static constexpr bool PERM = true, AFTER_DRAIN = false;
    bf16_t* Q; const float* rc; const float* rs; float qscale;
    __device__ __forceinline__ void operator()(const f32x4 (&acc)[2][2][4][2], const Unit& u, int wr, int wc, int fr, int fq) const {
        const int row0 = u.pm * BM + wr * 64 + fr, hh = 4 * u.pn + wc;
#pragma unroll
        for (int ai = 0; ai < 2; ++ai)
#pragma unroll
            for (int m = 0; m < 4; ++m) {
                const int row = row0 + ai * HALF + m * 16;
                const int pos = row < 65536 ? (row & 2047) : 4096 + ((row - 65536) & 63);
                float lo[8], hi[8];
#pragma unroll
                for (int n = 0; n < 2; ++n) {
                    const f32x4 c = *(const f32x4*)(rc + pos * 32 + 8 * fq + 4 * n), s = *(const f32x4*)(rs + pos * 32 + 8 * fq + 4 * n);
                    const f32x4 x1 = acc[ai][0][m][n], x2 = acc[ai][1][m][n];
#pragma unroll
                    for (int i = 0; i < 4; ++i) { lo[4 * n + i] = (x1[i] * c[i] - x2[i] * s[i]) * qscale; hi[4 * n + i] = (x1[i] * s[i] + x2[i] * c[i]) * qscale; }
                }
                bf16_t* dst = Q + (size_t)row * 1024 + 64 * hh + 8 * fq;
                u32x4 w; w.x = cvt_pk_bf16(lo[0], lo[1]); w.y = cvt_pk_bf16(lo[2], lo[3]); w.z = cvt_pk_bf16(lo[4], lo[5]); w.w = cvt_pk_bf16(lo[6], lo[7]);
                *(u32x4*)dst = w;
                w.x = cvt_pk_bf16(hi[0], hi[1]); w.y = cvt_pk_bf16(hi[2], hi[3]); w.z = cvt_pk_bf16(hi[4], hi[5]); w.w = cvt_pk_bf16(hi[6], hi[7]);
                *(u32x4*)(dst + 32) = w;
            }
    }
};
struct EpiKV {
    static constexpr bool PERM = true, AFTER_DRAIN = false;
    bf16_t *KBp, *VBp, *KCp, *VCp;
    float *pk, *pv, *sk, *sv;
    const float* rc; const float* rs;
    __device__ __forceinline__ void operator()(const f32x4 (&acc)[2][2][4][2], const Unit& u, int wr, int wc, int fr, int fq) const {
        const int row0 = u.pm * BM + wr * 64 + fr; const bool isk = u.pn < 4;
#pragma unroll
        for (int ai = 0; ai < 2; ++ai)
#pragma unroll
            for (int m = 0; m < 4; ++m) {
                const int row = row0 + ai * HALF + m * 16; const bool pr = row < 65536; const int rs_ = row - 65536;
                const int pos = pr ? (row & 2047) : 4096 + (rs_ & 63);
                const size_t brow = pr ? (size_t)row : (size_t)((rs_ >> 6) * 4160 + 4096 + (rs_ & 63));
                const size_t frow = pr ? (size_t)row : (size_t)rs_;
                if (isk) {
                    const int hh = 4 * u.pn + wc;
                    float lo[8], hi[8];
#pragma unroll
                    for (int n = 0; n < 2; ++n) {
                        const f32x4 c = *(const f32x4*)(rc + pos * 32 + 8 * fq + 4 * n), s = *(const f32x4*)(rs + pos * 32 + 8 * fq + 4 * n);
                        const f32x4 x1 = acc[ai][0][m][n], x2 = acc[ai][1][m][n];
#pragma unroll
                        for (int i = 0; i < 4; ++i) { lo[4 * n + i] = x1[i] * c[i] - x2[i] * s[i]; hi[4 * n + i] = x1[i] * s[i] + x2[i] * c[i]; }
                    }
                    bf16_t* dst = (pr ? KBp : KCp) + brow * 1024 + 64 * hh + 8 * fq;
                    u32x4 w; w.x = cvt_pk_bf16(lo[0], lo[1]); w.y = cvt_pk_bf16(lo[2], lo[3]); w.z = cvt_pk_bf16(lo[4], lo[5]); w.w = cvt_pk_bf16(lo[6], lo[7]);
                    *(u32x4*)dst = w;
                    w.x = cvt_pk_bf16(hi[0], hi[1]); w.y = cvt_pk_bf16(hi[2], hi[3]); w.z = cvt_pk_bf16(hi[4], hi[5]); w.w = cvt_pk_bf16(hi[6], hi[7]);
                    *(u32x4*)(dst + 32) = w;
                    float* fd = (pr ? pk : sk) + frow * 1024 + 64 * hh + 8 * fq;
                    *(f32x4*)fd = (f32x4){lo[0], lo[1], lo[2], lo[3]}; *(f32x4*)(fd + 4) = (f32x4){lo[4], lo[5], lo[6], lo[7]};
                    *(f32x4*)(fd + 32) = (f32x4){hi[0], hi[1], hi[2], hi[3]}; *(f32x4*)(fd + 36) = (f32x4){hi[4], hi[5], hi[6], hi[7]};
                } else {
                    const int col0 = (u.pn - 4) * BM + wc * 32 + 8 * fq;
#pragma unroll
                    for (int bj = 0; bj < 2; ++bj) {
                        const f32x4 a0 = acc[ai][bj][m][0], a1 = acc[ai][bj][m][1];
                        u32x4 w; w.x = cvt_pk_bf16(a0[0], a0[1]); w.y = cvt_pk_bf16(a0[2], a0[3]); w.z = cvt_pk_bf16(a1[0], a1[1]); w.w = cvt_pk_bf16(a1[2], a1[3]);
                        *(u32x4*)((pr ? VBp : VCp) + brow * 1024 + col0 + bj * HALF) = w;
                        float* fd = (pr ? pv : sv) + frow * 1024 + col0 + bj * HALF;
                        *(f32x4*)fd = a0; *(f32x4*)(fd + 4) = a1;
                    }
                }
            }
    }
};
template <class Epi, class Sched, bool ALIGN_EPI = false, bool SP2 = false>
__device__ __forceinline__ void gemm_phase(PG8_LAS unsigned char* lds, const Gemm g, const Sched& S, const Epi& E) {
    const int tid = threadIdx.x, wid = __builtin_amdgcn_readfirstlane(tid >> 6), lane = tid & 63, wr = wid >> 2, wc = wid & 3, fr = lane & 15, fq = lane >> 4;
    const int K = g.K, nt = K / BK;
    unsigned voffA[2], voffB[2];
#pragma unroll
    for (int i = 0; i < 2; ++i) { int R, C; stage_rc(tid * 16 + i * 8192, R, C); const int Rb = Epi::PERM ? ((R & ~31) + perm32(R & 31)) : R;
        voffA[i] = (unsigned)(R * K + C) * 2u; voffB[i] = (unsigned)(Rb * K + C) * 2u; }
    const size_t kstep = (size_t)(BK * 2);
    const size_t hstep = (size_t)HALF * K * 2;
    const size_t tstep = 2 * hstep;
    const unsigned ldsw = (unsigned)wid * 1024u;
    const int aoff = lds_byte(wr * 64 + fr, fq * 8), boff = lds_byte(wc * 32 + fr, fq * 8);
#define PG8_SA(b, h) (((b) * 2 + (h)) * HTB)
#define PG8_SB(b, h) ((4 + (b) * 2 + (h)) * HTB)
#define PG8_STAGE(bufoff, gbase, voff) do { _Pragma("unroll") for (int _i = 0; _i < 2; ++_i) \
        __builtin_amdgcn_global_load_lds((const unsigned*)((const char*)(gbase) + (voff)[_i]), (PG8_LAS unsigned*)(lds + (bufoff) + ldsw + _i * 8192), 16, 0, 0); } while (0)
#define PG8_LDA(dst, b, h) do { _Pragma("unroll") for (int m = 0; m < 4; ++m) _Pragma("unroll") for (int k = 0; k < 2; ++k) dst[m][k] = *(const PG8_LAS bf16x8*)(lds + PG8_SA(b, h) + aoff + m * 2048 + k * 1024); } while (0)
#define PG8_LDB(dst, b, h) do { _Pragma("unroll") for (int n = 0; n < 2; ++n) _Pragma("unroll") for (int k = 0; k < 2; ++k) dst[n][k] = *(const PG8_LAS bf16x8*)(lds + PG8_SB(b, h) + boff + n * 2048 + k * 1024); } while (0)
#define PG8_MMA(ai, bj, At, Bt) do { __builtin_amdgcn_s_setprio(1); _Pragma("unroll") for (int m = 0; m < 4; ++m) _Pragma("unroll") for (int n = 0; n < 2; ++n) _Pragma("unroll") for (int k = 0; k < 2; ++k) \
        acc[ai][bj][m][n] = __builtin_amdgcn_mfma_f32_16x16x32_bf16(Bt[n][k], At[m][k], acc[ai][bj][m][n], 0, 0, 0); __builtin_amdgcn_s_setprio(0); } while (0)
#define PG8_WAIT_V(n) asm volatile("s_waitcnt vmcnt(" #n ")" ::: "memory")
#define PG8_WAIT_L(n) asm volatile("s_waitcnt lgkmcnt(" #n ")" ::: "memory")
#define PG8_BAR __builtin_amdgcn_s_barrier()
#define PG8_SCHED __builtin_amdgcn_sched_barrier(0)
    Unit cur, nxt; int ui = 0;
    if (!S.next(0, cur)) return;
    f32x4 acc[2][2][4][2];
#pragma unroll
    for (int a = 0; a < 2; ++a)
#pragma unroll
        for (int b = 0; b < 2; ++b)
#pragma unroll
            for (int m = 0; m < 4; ++m)
#pragma unroll
                for (int n = 0; n < 2; ++n) acc[a][b][m][n] = (f32x4){0.f, 0.f, 0.f, 0.f};
    bf16x8 At[4][2], B0[2][2], B1[2][2];
    const char* cA = (const char*)g.A + (size_t)cur.pm * tstep; const char* cB = (const char*)g.Bt + (size_t)cur.pn * tstep;
    S.a_ready(cur);
    if constexpr (SP2) {
        PG8_STAGE(PG8_SB(0, 0), cB, voffB); PG8_STAGE(PG8_SB(0, 1), cB + hstep, voffB); PG8_STAGE(PG8_SA(0, 0), cA, voffA); PG8_STAGE(PG8_SA(0, 1), cA + hstep, voffA);
        if (wr == 1) PG8_BAR;
        PG8_WAIT_V(2); PG8_BAR;
        PG8_STAGE(PG8_SB(1, 0), cB + kstep, voffB); PG8_STAGE(PG8_SA(1, 0), cA + kstep, voffA); PG8_STAGE(PG8_SB(1, 1), cB + hstep + kstep, voffB);
        PG8_WAIT_V(6); PG8_BAR;
    } else {
        PG8_STAGE(PG8_SB(0, 0), cB, voffB); PG8_STAGE(PG8_SA(0, 0), cA, voffA); PG8_STAGE(PG8_SB(0, 1), cB + hstep, voffB); PG8_STAGE(PG8_SA(0, 1), cA + hstep, voffA);
        if (wr == 1) PG8_BAR;
        PG8_WAIT_V(4); PG8_BAR;
        PG8_STAGE(PG8_SB(1, 0), cB + kstep, voffB); PG8_STAGE(PG8_SA(1, 0), cA + kstep, voffA); PG8_STAGE(PG8_SB(1, 1), cB + hstep + kstep, voffB);
        PG8_WAIT_V(6); PG8_BAR;
    }
    for (;;) {
        const bool has_next = S.next(ui + 1, nxt);
        const char* nA = has_next ? (const char*)g.A + (size_t)nxt.pm * tstep : cA; const char* nB = has_next ? (const char*)g.Bt + (size_t)nxt.pn * tstep : cB;
        for (int t = 0; t < nt; t += 2) {
            const bool last = (t == nt - 2);
            const char* a1 = cA + (size_t)(t + 1) * kstep;
            const char* a2 = last ? nA : cA + (size_t)(t + 2) * kstep; const char* b2 = last ? nB : cB + (size_t)(t + 2) * kstep;
            const char* a3 = a2 + kstep; const char* b3 = b2 + kstep;
            if (last && has_next) S.a_ready(nxt);
            if constexpr (SP2) {
            PG8_LDB(B0, 0, 0); PG8_LDB(B1, 0, 1); PG8_SCHED; PG8_LDA(At, 0, 0); PG8_STAGE(PG8_SA(1, 1), a1 + hstep, voffA);
            PG8_WAIT_V(8); PG8_WAIT_L(0); PG8_BAR; PG8_MMA(0, 0, At, B0); PG8_MMA(0, 1, At, B1); PG8_BAR; PG8_SCHED;
            PG8_LDA(At, 0, 1); PG8_STAGE(PG8_SB(0, 0), b2, voffB); PG8_STAGE(PG8_SB(0, 1), b2 + hstep, voffB); PG8_STAGE(PG8_SA(0, 0), a2, voffA);
            PG8_WAIT_V(8); PG8_WAIT_L(0); PG8_BAR; PG8_MMA(1, 0, At, B0); PG8_MMA(1, 1, At, B1); PG8_BAR; PG8_SCHED;
            PG8_LDB(B0, 1, 0); PG8_LDB(B1, 1, 1); PG8_SCHED; PG8_LDA(At, 1, 0); PG8_STAGE(PG8_SA(0, 1), a2 + hstep, voffA);
            PG8_WAIT_V(8); PG8_WAIT_L(0); PG8_BAR; PG8_MMA(0, 0, At, B0); PG8_MMA(0, 1, At, B1); PG8_BAR; PG8_SCHED;
            PG8_LDA(At, 1, 1); PG8_STAGE(PG8_SB(1, 0), b3, voffB); PG8_STAGE(PG8_SB(1, 1), b3 + hstep, voffB); PG8_STAGE(PG8_SA(1, 0), a3, voffA);
            PG8_WAIT_V(8); PG8_WAIT_L(0); PG8_BAR; PG8_MMA(1, 0, At, B0); PG8_MMA(1, 1, At, B1); PG8_BAR; PG8_SCHED;
            } else {
            PG8_LDB(B0, 0, 0); PG8_SCHED; PG8_LDA(At, 0, 0); PG8_STAGE(PG8_SA(1, 1), a1 + hstep, voffA);
            PG8_WAIT_L(8); PG8_BAR; PG8_WAIT_L(0); PG8_MMA(0, 0, At, B0); PG8_BAR; PG8_SCHED;
            PG8_LDB(B1, 0, 1); PG8_STAGE(PG8_SB(0, 0), b2, voffB);
            PG8_BAR; PG8_WAIT_L(0); PG8_MMA(0, 1, At, B1); PG8_BAR;
            PG8_LDA(At, 0, 1); PG8_STAGE(PG8_SA(0, 0), a2, voffA);
            PG8_BAR; PG8_WAIT_L(0); PG8_MMA(1, 0, At, B0); PG8_BAR; PG8_SCHED;
            PG8_STAGE(PG8_SB(0, 1), b2 + hstep, voffB);
            PG8_WAIT_V(6); PG8_BAR; PG8_MMA(1, 1, At, B1); PG8_BAR;
            PG8_LDB(B0, 1, 0); PG8_SCHED; PG8_LDA(At, 1, 0); PG8_STAGE(PG8_SA(0, 1), a2 + hstep, voffA);
            PG8_WAIT_L(8); PG8_BAR; PG8_WAIT_L(0); PG8_MMA(0, 0, At, B0); PG8_BAR; PG8_SCHED;
            PG8_LDB(B1, 1, 1); PG8_STAGE(PG8_SB(1, 0), b3, voffB);
            PG8_BAR; PG8_WAIT_L(0); PG8_MMA(0, 1, At, B1); PG8_BAR;
            PG8_LDA(At, 1, 1); PG8_STAGE(PG8_SA(1, 0), a3, voffA);
            PG8_BAR; PG8_WAIT_L(0); PG8_MMA(1, 0, At, B0); PG8_BAR; PG8_SCHED;
            PG8_STAGE(PG8_SB(1, 1), b3 + hstep, voffB);
            PG8_WAIT_V(6); PG8_BAR; PG8_MMA(1, 1, At, B1); PG8_BAR;
            }
        }
        if constexpr (ALIGN_EPI) { if (wr == 0) PG8_BAR; }
        if constexpr (!Epi::AFTER_DRAIN) { E(acc, cur, wr, wc, fr, fq); S.done(cur); }
        if (!has_next) break;
#pragma unroll
        for (int a = 0; a < 2; ++a)
#pragma unroll
            for (int b = 0; b < 2; ++b)
#pragma unroll
                for (int m = 0; m < 4; ++m)
#pragma unroll
                    for (int n = 0; n < 2; ++n) acc[a][b][m][n] = (f32x4){0.f, 0.f, 0.f, 0.f};
        cur = nxt; cA = nA; cB = nB; ++ui;
        if constexpr (ALIGN_EPI) { if (wr == 1) PG8_BAR; }
    }
    PG8_WAIT_V(0);
    if constexpr (!ALIGN_EPI) { if (wr == 0) PG8_BAR; }
    PG8_BAR;
    if constexpr (Epi::AFTER_DRAIN) { E.fused(acc, cur, wr, wc, fr, fq, lds, wid, lane); S.done(cur); }
#undef PG8_SA
#undef PG8_SB
#undef PG8_STAGE
#undef PG8_LDA
#undef PG8_LDB
#undef PG8_MMA
#undef PG8_WAIT_V
#undef PG8_WAIT_L
#undef PG8_BAR
#undef PG8_SCHED
}
}
#ifndef PG8_SP2
#define PG8_SP2 true
#endif
namespace attn_body {
using bf16=__hip_bfloat16;
using bf16x8=__attribute__((ext_vector_type(8)))short;
using s16x4=__attribute__((ext_vector_type(4)))short;
using f32x16=__attribute__((ext_vector_type(16)))float;
using u32x4=__attribute__((ext_vector_type(4)))unsigned;
constexpr int D=64,DM=1024;
constexpr int NW=8,QBLK=32,KVBLK=64;
__device__ __forceinline__ int crow(int r,int hi){return (r&3)+8*(r>>2)+4*hi;}
#define SBAR() __builtin_amdgcn_sched_barrier(0)
constexpr int NSLOT=3, SLOTB=8192, RSLOT=2*SLOTB;
constexpr int LDS_K=0, LDS_V=NSLOT*RSLOT, LDS_WS=2*NSLOT*RSLOT, LDS_OST=LDS_WS+NW*64*4, LDS_BYTES=LDS_OST+NW*4096;
constexpr float C2=0.125f*1.4426950408889634f;
__device__ __forceinline__ void glds16(const void*gsrc,unsigned lds_dst){unsigned keep;
  asm volatile("s_mov_b32 %0, m0\n\ts_mov_b32 m0, %2\n\ts_nop 0\n\tglobal_load_lds_dwordx4 %1, off\n\ts_mov_b32 m0, %0":"=&s"(keep):"v"(gsrc),"s"(lds_dst):"memory");}
__device__ __forceinline__ void glds16s(const void*sbase,unsigned voff,unsigned lds_dst){unsigned keep;
  asm volatile("s_mov_b32 %0, m0\n\ts_mov_b32 m0, %3\n\ts_nop 4\n\tglobal_load_lds_dwordx4 %1, %2\n\ts_mov_b32 m0, %0":"=&s"(keep):"v"(voff),"s"(sbase),"s"(lds_dst):"memory");}
__device__ __forceinline__ const char* uni64(const void*p){ const unsigned long long v=(unsigned long long)p; const unsigned lo=__builtin_amdgcn_readfirstlane((unsigned)v),hi=__builtin_amdgcn_readfirstlane((unsigned)(v>>32)); return (const char*)(((unsigned long long)hi<<32)|lo); }
__device__ __forceinline__ float max3f(float a,float b,float c){float r;asm("v_max3_f32 %0, %1, %2, %3":"=v"(r):"v"(a),"v"(b),"v"(c));return r;}
__device__ __forceinline__ float max2f(float a,float b){float r;asm("v_max_f32_e32 %0, %1, %2":"=v"(r):"v"(a),"v"(b));return r;}
__device__ __forceinline__ float fadd_s(float a,float b){float r;asm("v_add_f32_e32 %0, %1, %2":"=v"(r):"v"(a),"v"(b));return r;}
__device__ __forceinline__ float fsub_s(float a,float b){float r;asm("v_sub_f32_e32 %0, %1, %2":"=v"(r):"v"(a),"v"(b));return r;}
typedef float f32x2_t __attribute__((ext_vector_type(2))); typedef __bf16 bf16x2_t __attribute__((ext_vector_type(2)));
__device__ __forceinline__ unsigned cvtpk_s(float lo,float hi){f32x2_t v={lo,hi};bf16x2_t b=__builtin_convertvector(v,bf16x2_t);return __builtin_bit_cast(unsigned,b);}
#define WAIT_BAR(N) asm volatile("s_waitcnt vmcnt(" #N ") lgkmcnt(0)\n\ts_barrier":::"memory")

__device__ __forceinline__ void qkt(f32x16&p0,f32x16&p1,const char*Kslot,const bf16x8*qr,const f32x16&negm,int r32,int hi){
  const char*kb=Kslot+hi*1024+r32*16;
  #pragma unroll
  for(int d0=0;d0<4;++d0){
    const bf16x8 b0=*reinterpret_cast<const bf16x8*>(kb+d0*2048);
    const bf16x8 b1=*reinterpret_cast<const bf16x8*>(kb+d0*2048+512);
    if(d0==0){p0=__builtin_amdgcn_mfma_f32_32x32x16_bf16(b0,qr[0],negm,0,0,0);p1=__builtin_amdgcn_mfma_f32_32x32x16_bf16(b1,qr[0],negm,0,0,0);}
    else{p0=__builtin_amdgcn_mfma_f32_32x32x16_bf16(b0,qr[d0],p0,0,0,0);p1=__builtin_amdgcn_mfma_f32_32x32x16_bf16(b1,qr[d0],p1,0,0,0);}}
}
typedef __attribute__((address_space(3))) const char* lds_cptr;
typedef short v4i16_t __attribute__((ext_vector_type(4)));
__device__ __forceinline__ void kload8(bf16x8*kf,lds_cptr kp){
  kf[0]=*(const __attribute__((address_space(3))) bf16x8*)(kp);      kf[1]=*(const __attribute__((address_space(3))) bf16x8*)(kp+512);
  kf[2]=*(const __attribute__((address_space(3))) bf16x8*)(kp+2048); kf[3]=*(const __attribute__((address_space(3))) bf16x8*)(kp+2560);
  kf[4]=*(const __attribute__((address_space(3))) bf16x8*)(kp+4096); kf[5]=*(const __attribute__((address_space(3))) bf16x8*)(kp+4608);
  kf[6]=*(const __attribute__((address_space(3))) bf16x8*)(kp+6144); kf[7]=*(const __attribute__((address_space(3))) bf16x8*)(kp+6656);
}
__device__ __forceinline__ void kload2(bf16x8*kf,lds_cptr kp,int j){ kf[2*j]=*(const __attribute__((address_space(3))) bf16x8*)(kp+j*2048); kf[2*j+1]=*(const __attribute__((address_space(3))) bf16x8*)(kp+j*2048+512); }
__device__ __forceinline__ s16x4 vtr(lds_cptr p){ return __builtin_bit_cast(s16x4,__builtin_amdgcn_ds_read_tr16_b64_v4i16((__attribute__((address_space(3))) v4i16_t*)p)); }
__device__ __forceinline__ float rowmax(const f32x16&p0,const f32x16&p1){
  float a=max3f(p0[0],p0[1],p1[0]),b=max3f(p0[2],p0[3],p1[1]);a=max3f(a,p1[2],p1[3]);
  #pragma unroll
  for(int r=4;r<16;r+=4){a=max3f(a,p0[r],p0[r+1]);b=max3f(b,p0[r+2],p0[r+3]);a=max3f(a,p1[r],p1[r+1]);b=max3f(b,p1[r+2],p1[r+3]);}
  const float m=max2f(a,b);
  auto rr=__builtin_amdgcn_permlane32_swap(__float_as_uint(m),__float_as_uint(m),false,false);
  return max2f(__uint_as_float(rr[0]),__uint_as_float(rr[1]));
}
__device__ __forceinline__ void pv(f32x16*o,int vb,bf16x8 pa0,bf16x8 pa1,bf16x8 pa2,bf16x8 pa3){
  #pragma unroll
  for(int d0=0;d0<2;++d0){s16x4 lo[4],hi[4];
    #pragma unroll
    for(int ks=0;ks<4;++ks){
      asm volatile("ds_read_b64_tr_b16 %0,%1 offset:%c2":"=&v"(lo[ks]):"v"(vb),"i"(d0*4096+ks*1024):"memory");
      asm volatile("ds_read_b64_tr_b16 %0,%1 offset:%c2":"=&v"(hi[ks]):"v"(vb),"i"(d0*4096+ks*1024+512):"memory");}
    asm volatile("s_waitcnt lgkmcnt(0)":::"memory");SBAR();
    #define PK(k) (bf16x8){lo[k][0],lo[k][1],lo[k][2],lo[k][3],hi[k][0],hi[k][1],hi[k][2],hi[k][3]}
    o[d0]=__builtin_amdgcn_mfma_f32_32x32x16_bf16(pa0,PK(0),o[d0],0,0,0);
    o[d0]=__builtin_amdgcn_mfma_f32_32x32x16_bf16(pa1,PK(1),o[d0],0,0,0);
    o[d0]=__builtin_amdgcn_mfma_f32_32x32x16_bf16(pa2,PK(2),o[d0],0,0,0);
    o[d0]=__builtin_amdgcn_mfma_f32_32x32x16_bf16(pa3,PK(3),o[d0],0,0,0);
    #undef PK
  }
}

#ifndef ATTN_STORE16
#define ATTN_STORE16(p,v) (*(u32x4*)(p)=(v))
#endif
template<int THRL> __device__ __forceinline__ void attn_unit(const bf16*Qw,const bf16*__restrict__ Kh,const bf16*__restrict__ Vh,bf16*Ow,int NTr,char*shm){
  const int tid=threadIdx.x,lane=tid&63,r32=lane&31,hi=lane>>5; const int wid=__builtin_amdgcn_readfirstlane(tid>>6);
  const int wm=wid>>2, wv=(wid>>1)&1;
  const unsigned lds0=(unsigned)(uintptr_t)shm;
  float*wsf=(float*)(shm+LDS_WS)+wid*64;
  const char*Kb=uni64(Kh); const char*Vb=uni64(Vh);
  const unsigned kvoff=(unsigned)((lane*DM+wid*8)*2);
  const unsigned vvoff=(unsigned)(((16*(wid&3)+(lane>>2))*DM+(wid>>2)*32+(lane&3)*8)*2);
  const unsigned kdst=lds0+LDS_K+wid*1024, vdst=lds0+LDS_V+wid*1024;
  const int NT=(NTr<=4)?4:((NTr+1)&~1); const int tmax=NTr-1;
  #define TCL(t) (((t)<tmax)?(t):tmax)
  #define DMA_K(t,slot) do{ const char*b_=Kb+(long)TCL(t)*(KVBLK*DM*2); glds16s(b_,kvoff,(unsigned)__builtin_amdgcn_readfirstlane(kdst+(slot))); glds16s(b_+128,kvoff,(unsigned)__builtin_amdgcn_readfirstlane(kdst+SLOTB+(slot))); }while(0)
  #define DMA_V(t,slot) do{ const char*b_=Vb+(long)TCL(t)*(KVBLK*DM*2); glds16s(b_,vvoff,(unsigned)__builtin_amdgcn_readfirstlane(vdst+(slot))); glds16s(b_+128,vvoff,(unsigned)__builtin_amdgcn_readfirstlane(vdst+SLOTB+(slot))); }while(0)
  const int vb0=(int)(lds0+LDS_V)+wv*SLOTB+((lane>>4)&1)*32+(lane&3)*8+(4*hi+((lane&15)>>2))*64;
  const char*Kbase=shm+LDS_K+wm*SLOTB; bf16x8 kf[8];
  const lds_cptr shm3=(lds_cptr)shm; const lds_cptr kp0=shm3+LDS_K+wm*SLOTB+hi*1024+r32*16; const lds_cptr vp0=shm3+LDS_V+wv*SLOTB+((lane>>4)&1)*32+(lane&3)*8+(4*hi+((lane&15)>>2))*64;
  DMA_K(0,0);DMA_V(0,0);DMA_K(1,RSLOT);
  bf16x8 qr[4];
  #pragma unroll
  for(int d0=0;d0<4;++d0)qr[d0]=*reinterpret_cast<const bf16x8*>(&Qw[(long)r32*DM+d0*16+hi*8]);
  float mhat=0.f,l_reg=0.f;f32x16 o[2];o[0]=f32x16{};o[1]=f32x16{};f32x16 negm; _Pragma("unroll") for(int r_=0;r_<16;++r_){ float z_; asm volatile("v_mov_b32 %0, 0":"=v"(z_)); negm[r_]=z_; }
  #define CMASK(P0,P1,t) do{ if((t)>=NTr){ _Pragma("unroll") for(int r_=0;r_<16;++r_){P0[r_]=-INFINITY;P1[r_]=-INFINITY;} } }while(0)
  bool resc=false;
  #define START(P0,P1) do{ const float rm=rowmax(P0,P1); resc=false; \
    { const float dl=rm; mhat=fadd_s(mhat,dl); \
      _Pragma("unroll") for(int r=0;r<16;++r){P0[r]=fsub_s(P0[r],dl);P1[r]=fsub_s(P1[r],dl);} \
      _Pragma("unroll") for(int r=0;r<16;++r)negm[r]=-mhat; asm volatile("":"+v"(negm)); } \
    _Pragma("unroll") for(int r=0;r<16;++r)P0[r]=__builtin_amdgcn_exp2f(P0[r]); }while(0)
  #define RESC() do{ if(resc){ asm volatile("s_waitcnt lgkmcnt(0)":::"memory"); \
      _Pragma("unroll") for(int d_=0;d_<2;++d_) _Pragma("unroll") for(int r=0;r<16;++r)o[d_][r]*=wsf[crow(r,hi)]; } }while(0)
  f32x16 pA0,pA1,pB0,pB1;
  int sl_prev=0,sl_cur=0,sl_next=RSLOT;
  #define ROT() do{sl_prev=sl_cur;sl_cur=sl_next;sl_next=(sl_next==(NSLOT-1)*RSLOT)?0:sl_next+RSLOT;}while(0)
  DMA_K(2,2*RSLOT);
  WAIT_BAR(6);
  qkt(pA0,pA1,Kbase,qr,negm,r32,hi);asm volatile("s_nop 15\n\ts_nop 7":"+v"(pA0),"+v"(pA1));
  START(pA0,pA1);
  _Pragma("unroll") for(int r=0;r<16;++r)pA1[r]=__builtin_amdgcn_exp2f(pA1[r]);
  WAIT_BAR(0);
  DMA_K(3,0);DMA_V(1,RSLOT);
  ROT();
  kload8(kf,kp0+sl_cur);
  WAIT_BAR(4);
  s16x4 vlo[8],vhi[8]; u32x4 pw0,pw1,pw2,pw3;
  #define PKW(P,B) cvtpk_s(P[B],P[B+1])
  #define PAF(k) __builtin_bit_cast(bf16x8,pw##k)
  #define VFR(i) (bf16x8){vlo[i][0],vlo[i][1],vlo[i][2],vlo[i][3],vhi[i][0],vhi[i][1],vhi[i][2],vhi[i][3]}
  #define PIN(x) asm volatile("":"+v"(x))
  #define MX3(a,b,c) __builtin_fmaxf(__builtin_fmaxf((a),(b)),(c))
  #define GAPA(MF,A0,A1,A2,A3,W0,W1,PW) do{ MF; sacc+=A0; sacc+=A1; sacc+=A2; sacc+=A3; PIN(sacc); W0; W1; PIN(PW); SBAR(); }while(0)
  #define EX(v) __builtin_amdgcn_exp2f(v)
  #define GAPB(MF,X,B) do{ MF; X[B]=EX(X[B]); X[B+1]=EX(X[B+1]); X[B+2]=EX(X[B+2]); X[B+3]=EX(X[B+3]); PIN(X); SBAR(); }while(0)
  #define VRD(i) do{ vlo[i]=vtr(vp_+(((i)>>2)*4096+((i)&3)*1024)); vhi[i]=vtr(vp_+(((i)>>2)*4096+((i)&3)*1024+512)); }while(0)
  #define KRD(G,j) do{ if(G){ kload2(kf,kp0+sl_next,j); SBAR(); } }while(0)
  #define STEP(C0,C1,P0,P1,t,GK,GV,GL) do{ SBAR(); \
    const lds_cptr vp_=vp0+sl_prev; \
    VRD(0); SBAR(); float sacc=(P0[0]+P0[1]); \
    GAPA(C0=__builtin_amdgcn_mfma_f32_32x32x16_bf16(kf[0],qr[0],negm,0,0,0), P0[2],P0[3],P0[4],P0[5],     pw0[0]=PKW(P0,0), pw0[1]=PKW(P0,2), pw0); \
    VRD(4); SBAR(); GAPA(C1=__builtin_amdgcn_mfma_f32_32x32x16_bf16(kf[1],qr[0],negm,0,0,0), P0[6],P0[7],P0[8],P0[9],     pw0[2]=PKW(P0,4), pw0[3]=PKW(P0,6), pw0); \
    VRD(1); SBAR(); GAPA(C0=__builtin_amdgcn_mfma_f32_32x32x16_bf16(kf[2],qr[1],C0,0,0,0),   P0[10],P0[11],P0[12],P0[13], pw1[0]=PKW(P0,8), pw1[1]=PKW(P0,10), pw1); \
    VRD(5); SBAR(); GAPA(C1=__builtin_amdgcn_mfma_f32_32x32x16_bf16(kf[3],qr[1],C1,0,0,0),   P0[14],P0[15],P1[0],P1[1],   pw1[2]=PKW(P0,12),pw1[3]=PKW(P0,14), pw1); \
    VRD(2); SBAR(); GAPA(C0=__builtin_amdgcn_mfma_f32_32x32x16_bf16(kf[4],qr[2],C0,0,0,0),   P1[2],P1[3],P1[4],P1[5],     pw2[0]=PKW(P1,0), pw2[1]=PKW(P1,2), pw2); \
    VRD(6); SBAR(); GAPA(C1=__builtin_amdgcn_mfma_f32_32x32x16_bf16(kf[5],qr[2],C1,0,0,0),   P1[6],P1[7],P1[8],P1[9],     pw2[2]=PKW(P1,4), pw2[3]=PKW(P1,6), pw2); \
    VRD(3); SBAR(); GAPA(C0=__builtin_amdgcn_mfma_f32_32x32x16_bf16(kf[6],qr[3],C0,0,0,0),   P1[10],P1[11],P1[12],P1[13], pw3[0]=PKW(P1,8), pw3[1]=PKW(P1,10), pw3); \
    VRD(7); SBAR(); GAPA(C1=__builtin_amdgcn_mfma_f32_32x32x16_bf16(kf[7],qr[3],C1,0,0,0),   P1[14],P1[15],0.f,0.f,       pw3[2]=PKW(P1,12),pw3[3]=PKW(P1,14), pw3); \
    l_reg+=sacc; \
    if(GK){DMA_K((t)+3,sl_cur);} if(GV){DMA_V((t)+1,sl_next);} \
    CMASK(C0,C1,t); \
    { float a=MX3(C0[0],C0[1],C1[0]),b=MX3(C0[2],C0[3],C1[1]); a=MX3(a,C1[2],C1[3]); \
      _Pragma("unroll") for(int r=4;r<16;r+=4){a=MX3(a,C0[r],C0[r+1]);b=MX3(b,C0[r+2],C0[r+3]);a=MX3(a,C1[r],C1[r+1]);b=MX3(b,C1[r+2],C1[r+3]);} \
      float rm=__builtin_fmaxf(a,b); { auto rr=__builtin_amdgcn_permlane32_swap(__float_as_uint(rm),__float_as_uint(rm),false,false); rm=__builtin_fmaxf(__uint_as_float(rr[0]),__uint_as_float(rr[1])); } \
      resc=false; \
      if(__builtin_expect(__any(rm>(float)THRL),0)){ const float dl=__builtin_fmaxf(rm,0.f); mhat+=dl; \
        _Pragma("unroll") for(int r=0;r<16;++r){C0[r]-=dl;C1[r]-=dl;} \
        _Pragma("unroll") for(int r=0;r<16;++r)negm[r]=-mhat; asm volatile("":"+v"(negm)); \
        const float f=__builtin_amdgcn_exp2f(-dl); l_reg*=f; if(hi==0)wsf[r32]=f; resc=true; } } \
    SBAR(); \
    GAPB(o[0]=__builtin_amdgcn_mfma_f32_32x32x16_bf16(PAF(0),VFR(0),o[0],0,0,0), C0,0); \
    GAPB(o[1]=__builtin_amdgcn_mfma_f32_32x32x16_bf16(PAF(0),VFR(4),o[1],0,0,0), C0,4); \
    KRD(GL,0); GAPB(o[0]=__builtin_amdgcn_mfma_f32_32x32x16_bf16(PAF(1),VFR(1),o[0],0,0,0), C0,8); \
    KRD(GL,1); GAPB(o[1]=__builtin_amdgcn_mfma_f32_32x32x16_bf16(PAF(1),VFR(5),o[1],0,0,0), C0,12); \
    KRD(GL,2); GAPB(o[0]=__builtin_amdgcn_mfma_f32_32x32x16_bf16(PAF(2),VFR(2),o[0],0,0,0), C1,0); \
    KRD(GL,3); GAPB(o[1]=__builtin_amdgcn_mfma_f32_32x32x16_bf16(PAF(2),VFR(6),o[1],0,0,0), C1,4); \
    GAPB(o[0]=__builtin_amdgcn_mfma_f32_32x32x16_bf16(PAF(3),VFR(3),o[0],0,0,0), C1,8); \
    GAPB(o[1]=__builtin_amdgcn_mfma_f32_32x32x16_bf16(PAF(3),VFR(7),o[1],0,0,0), C1,12); \
    }while(0)
  int t=1;
  #undef CMASK
  #define CMASK(P0,P1,t) do{}while(0)
  for(;t+5<NT;t+=2){
    STEP(pB0,pB1,pA0,pA1,t,true,true,true);     WAIT_BAR(4); RESC(); ROT();
    STEP(pA0,pA1,pB0,pB1,t+1,true,true,true);   WAIT_BAR(4); RESC(); ROT();
  }
  #undef CMASK
  #define CMASK(P0,P1,t) do{ if((t)>=NTr){ _Pragma("unroll") for(int r_=0;r_<16;++r_){P0[r_]=-INFINITY;P1[r_]=-INFINITY;} } }while(0)
  #define ENDW(tt) do{ if((tt)+3<NT){WAIT_BAR(4);} else if((tt)+2<NT){WAIT_BAR(2);} else {WAIT_BAR(0);} }while(0)
  for(;t+1<NT;t+=2){
    STEP(pB0,pB1,pA0,pA1,t,(t+3<NT),(t+1<NT),(t+1<NT));       ENDW(t);   RESC(); ROT();
    STEP(pA0,pA1,pB0,pB1,t+1,(t+4<NT),(t+2<NT),(t+2<NT));     ENDW(t+1); RESC(); ROT();
  }
  STEP(pB0,pB1,pA0,pA1,NT-1,false,false,false); RESC();
  { float sacc=pB0[0]+pB0[1]; _Pragma("unroll") for(int r=2;r<16;++r)sacc+=pB0[r]; _Pragma("unroll") for(int r=0;r<16;++r)sacc+=pB1[r]; l_reg+=sacc;
    pw0=(u32x4){PKW(pB0,0),PKW(pB0,2),PKW(pB0,4),PKW(pB0,6)};pw1=(u32x4){PKW(pB0,8),PKW(pB0,10),PKW(pB0,12),PKW(pB0,14)};pw2=(u32x4){PKW(pB1,0),PKW(pB1,2),PKW(pB1,4),PKW(pB1,6)};pw3=(u32x4){PKW(pB1,8),PKW(pB1,10),PKW(pB1,12),PKW(pB1,14)};
    SBAR(); pv(o,vb0+sl_cur,PAF(0),PAF(1),PAF(2),PAF(3)); }
  #undef PKW
  #undef PAF
  #undef VFR
  #undef PIN
  #undef MX3
  #undef GAPA
  #undef GAPB
  #undef EX
  #undef VRD
  #undef KRD
  #undef STEP
  #undef ENDW
  {auto rr=__builtin_amdgcn_permlane32_swap(__float_as_uint(l_reg),__float_as_uint(l_reg),false,false);l_reg=__uint_as_float(rr[0])+__uint_as_float(rr[1]);}
  if(hi==0)wsf[32+r32]=l_reg;asm volatile("s_waitcnt lgkmcnt(0)":::"memory");
  float rli[16];
  #pragma unroll
  for(int r=0;r<16;++r)rli[r]=__builtin_amdgcn_rcpf(wsf[32+crow(r,hi)]);
  { bf16*stg=(bf16*)(shm+LDS_OST)+wid*2048;
    #pragma unroll
    for(int r=0;r<16;++r){const int orow=crow(r,hi);
      #pragma unroll
      for(int d0=0;d0<2;++d0)stg[orow*64+d0*32+r32]=__float2bfloat16(o[d0][r]*rli[r]);}
    asm volatile("s_waitcnt lgkmcnt(0)":::"memory");
    #pragma unroll
    for(int i=0;i<4;++i){const int row=i*8+(lane>>3),ch=lane&7; const u32x4 v=*(const u32x4*)(stg+row*64+ch*8); ATTN_STORE16(Ow+(long)row*DM+ch*8,v);} }
  asm volatile("s_waitcnt lgkmcnt(0)\n\ts_barrier":::"memory");
  #undef DMA_K
  #undef DMA_V
  #undef TCL
  #undef CMASK
  #undef START
  #undef RESC
  #undef ROT
}
constexpr int ATTN_LDS_BYTES=LDS_BYTES;
#undef SBAR
#undef WAIT_BAR
}
constexpr int NWAVES = 8;
#ifndef MK_ONE_LAUNCH
#define MK_ONE_LAUNCH 1
#endif
constexpr int DMODEL = 1024, DFF = 2816, MP = 65536, MS = 2048, MT = MP + MS;
constexpr int NSTREAM_P = 32, SEQ_P = 2048, NSTREAM_S = 32, SEQ_S = 64, PAST = 4096, KCL = PAST + SEQ_S;
constexpr int NPHASE = 22;
constexpr float LN_EPSF = 1e-5f, RMS_EPSF = 1e-5f;
constexpr float LAM_INIT = 0.35550906759096924f;
constexpr size_t O_Y = 0, O_PSR = (size_t)MT * 1024, O_PSI = O_PSR + 131072, O_PK = O_PSI + 131072, O_PV = O_PK + (size_t)MP * 1024,
                 O_SSR = O_PV + (size_t)MP * 1024, O_SSI = O_SSR + 131072, O_SK = O_SSI + 131072, O_SV = O_SK + (size_t)MS * 1024, O_END = O_SV + (size_t)MS * 1024;
static_assert(O_END == 208142336ull, "output size");
constexpr size_t MiB = 1u << 20;
constexpr size_t WS_CTL = 0, CTL_ZERO_BYTES = 1 * MiB;
constexpr size_t WS_RC = 1 * MiB, WS_RS = 2 * MiB;
constexpr size_t WS_S5 = 3 * MiB;
constexpr size_t WS_WIN = 4 * MiB, WIN_BYTES = 11 * MiB;
constexpr size_t WS_WOUT = 48 * MiB, WOUT_BYTES = 5767168;
constexpr size_t WS_WGLU = 72 * MiB, WS_WQ = 76 * MiB, WS_WKV = 78 * MiB, WS_WO = 82 * MiB;
constexpr size_t WS_XB = 84 * MiB;
constexpr size_t WS_TB = WS_XB + 132 * MiB;
constexpr size_t WS_HB = WS_TB + 132 * MiB;
constexpr size_t WS_ZB = WS_HB, WS_QB = WS_HB, WS_O2 = WS_HB + 132 * MiB;
constexpr size_t WS_KB = WS_HB + 363 * MiB, WS_VB = WS_KB + 128 * MiB;
constexpr size_t WS_KC = WS_VB + 128 * MiB, WS_VC = WS_KC + 260 * MiB;
constexpr size_t WS_END = WS_VC + 260 * MiB;
static_assert(WS_WOUT + 4 * WOUT_BYTES <= WS_WGLU && WS_WIN + 4 * WIN_BYTES <= WS_WOUT, "weight map");
constexpr int CW_TMO = 0, CW_BAR = 4096;
constexpr int RING_BYTES = 133120;
constexpr int LDSCTL_OFF = 135168, MISC_OFF = LDSCTL_OFF + 320, LDS_BYTES = 147456;
static_assert(attn_body::ATTN_LDS_BYTES <= RING_BYTES && pg8::STAGE_BYTES <= RING_BYTES && MISC_OFF + 128 <= LDS_BYTES, "LDS map");

#define GAS __attribute__((address_space(1)))
#define LAS __attribute__((address_space(3)))
typedef unsigned short bf16;
typedef unsigned v4u __attribute__((ext_vector_type(4)));
typedef unsigned v2u __attribute__((ext_vector_type(2)));
typedef float f32x4 __attribute__((ext_vector_type(4)));
typedef GAS unsigned gu32;
#define RLX_AGENT __ATOMIC_RELAXED, __HIP_MEMORY_SCOPE_AGENT
#define LDS_WAIT() asm volatile("s_waitcnt lgkmcnt(0)" ::: "memory")
#define VM_WAIT() asm volatile("s_waitcnt vmcnt(0)" ::: "memory")
__device__ __forceinline__ unsigned f2bf(float f) { unsigned u = __builtin_bit_cast(unsigned, f); return (u + 0x7fffu + ((u >> 16) & 1u)) >> 16; }
__device__ __forceinline__ unsigned pk2(float lo, float hi) { return f2bf(lo) | (f2bf(hi) << 16); }
__device__ __forceinline__ float bflo(unsigned w) { return __uint_as_float(w << 16); }
__device__ __forceinline__ float bfhi(unsigned w) { return __uint_as_float(w & 0xffff0000u); }
__device__ __forceinline__ float wave_sum(float v) {
#pragma unroll
    for (int o = 1; o < 64; o <<= 1) v += __shfl_xor(v, o);
    return v;
}
#define XB_TMO      128
#define XB_XCNT(j)  (256  + 64 * (j))
#define XB_XSUB(j)  (1280 + 64 * (j))
#define XB_XGEN(j)  (2304 + 64 * (j))
#define XB_TOP      3328
#define XB_TOPGEN   3392
#define XCD_BAR_WORDS 3456
#define XB_SPIN_CAP (1u << 18)

__device__ __forceinline__ unsigned xb_ld(unsigned* p)              { return __hip_atomic_load(p, __ATOMIC_RELAXED, __HIP_MEMORY_SCOPE_AGENT); }
__device__ __forceinline__ unsigned xb_add(unsigned* p, unsigned v) { return __hip_atomic_fetch_add(p, v, __ATOMIC_RELAXED, __HIP_MEMORY_SCOPE_AGENT); }
__device__ __forceinline__ unsigned xb_xcc_id() { return (unsigned)__builtin_amdgcn_s_getreg((3 << 11) | 20) & 0xFu; }
#define XB_SPIN(cond, bar) do { unsigned _sp = 0; while (cond) { __builtin_amdgcn_s_sleep(1); \
    if ((++_sp & 255u) == 0u) { if (xb_ld(&(bar)[XB_TMO])) break; if (_sp > XB_SPIN_CAP) { atomicAdd(&(bar)[XB_TMO], 1u); break; } } } } while (0)

struct XcdBarrier {
    unsigned* bar; unsigned x;
    volatile LAS unsigned* st;
};

__device__ __forceinline__ XcdBarrier xcd_barrier_post(unsigned* bar, volatile LAS unsigned* st) {
    XcdBarrier b; b.bar = bar; b.x = xb_xcc_id(); b.st = st;
    if (threadIdx.x == 0) (void)xb_add(&bar[XB_XCNT(b.x)], 1u);
    return b;
}
__device__ __forceinline__ void xcd_barrier_complete(unsigned* bar, unsigned x, unsigned& nloc, unsigned& nx) {
    const unsigned G = gridDim.x * gridDim.y * gridDim.z;
    unsigned sum, cnt, mine, sp = 0u;
    for (;;) {
        sum = 0u; cnt = 0u; mine = 0u;
#pragma unroll
        for (unsigned j = 0; j < 16; ++j) { const unsigned c = xb_ld(&bar[XB_XCNT(j)]); sum += c; cnt += (c > 0u) ? 1u : 0u; mine = (j == x) ? c : mine; }
        if (sum == G) break;
        __builtin_amdgcn_s_sleep(1);
        if ((++sp & 255u) == 0u) { if (xb_ld(&bar[XB_TMO])) break; if (sp > XB_SPIN_CAP) { atomicAdd(&bar[XB_TMO], 1u); break; } }
    }
    nloc = mine > 0u ? mine : 1u; nx = cnt > 0u ? cnt : 1u;
}

__device__ __forceinline__ void xcd_barrier(const XcdBarrier& b) {
    asm volatile("s_waitcnt vmcnt(0)" ::: "memory");
    __syncthreads();
    if (threadIdx.x == 0) {
        unsigned* bar = b.bar;
        __builtin_amdgcn_s_waitcnt(0);
        unsigned nloc = b.st[0], nx = b.st[1];
        if (nloc == 0u) { xcd_barrier_complete(bar, b.x, nloc, nx); b.st[0] = nloc; b.st[1] = nx; }
        const unsigned old = xb_add(&bar[XB_XSUB(b.x)], 1u);
        const unsigned gen = old / nloc;
        if (old + 1u == (gen + 1u) * nloc) {
            __builtin_amdgcn_fence(__ATOMIC_RELEASE, "agent");
            asm volatile("s_waitcnt vmcnt(0)" ::: "memory");
            const unsigned og = xb_add(&bar[XB_TOP], 1u);
            const unsigned tg = og / nx;
            if (og + 1u == (tg + 1u) * nx) xb_add(&bar[XB_TOPGEN], 1u);
            else XB_SPIN(xb_ld(&bar[XB_TOPGEN]) == tg, bar);
            __builtin_amdgcn_fence(__ATOMIC_ACQUIRE, "agent");
            xb_add(&bar[XB_XGEN(b.x)], 1u);
            asm volatile("s_waitcnt vmcnt(0)" ::: "memory");
        } else {
            XB_SPIN(xb_ld(&bar[XB_XGEN(b.x)]) == gen, bar);
            __builtin_amdgcn_fence(__ATOMIC_ACQUIRE, "agent");
            asm volatile("s_waitcnt vmcnt(0)" ::: "memory");
        }
    }
    __syncthreads();
}
__device__ __forceinline__ void dsincos(double x, double& s, double& c) {
    const double k = __builtin_rint(x * 0.63661977236758134308);
    double r = __builtin_fma(-k, 1.57079632679489655800e+00, x); r = __builtin_fma(-k, 6.12323399573676603587e-17, r);
    const double z = r * r;
    double sp = 1.0 / 355687428096000.0;
    sp = __builtin_fma(sp, z, -1.0 / 1307674368000.0); sp = __builtin_fma(sp, z, 1.0 / 6227020800.0); sp = __builtin_fma(sp, z, -1.0 / 39916800.0); sp = __builtin_fma(sp, z, 1.0 / 362880.0);
    sp = __builtin_fma(sp, z, -1.0 / 5040.0); sp = __builtin_fma(sp, z, 1.0 / 120.0); sp = __builtin_fma(sp, z, -1.0 / 6.0); sp = __builtin_fma(sp, z, 1.0);
    const double sr = sp * r;
    double cp = -1.0 / 6402373705728000.0;
    cp = __builtin_fma(cp, z, 1.0 / 20922789888000.0); cp = __builtin_fma(cp, z, -1.0 / 87178291200.0); cp = __builtin_fma(cp, z, 1.0 / 479001600.0); cp = __builtin_fma(cp, z, -1.0 / 3628800.0);
    cp = __builtin_fma(cp, z, 1.0 / 40320.0); cp = __builtin_fma(cp, z, -1.0 / 720.0); cp = __builtin_fma(cp, z, 1.0 / 24.0); cp = __builtin_fma(cp, z, -0.5); cp = __builtin_fma(cp, z, 1.0);
    const int q = (int)((long long)k & 3);
    s = (q == 0) ? sr : (q == 1) ? cp : (q == 2) ? -sr : -cp;
    c = (q == 0) ? cp : (q == 1) ? -sr : (q == 2) ? -cp : sr;
}
__device__ __forceinline__ double dexp(double x) {
    const double n = __builtin_rint(x * 1.44269504088896338700e+00);
    double r = __builtin_fma(-n, 6.93147180369123816490e-01, x); r = __builtin_fma(-n, 1.90821492927058770002e-10, r);
    double p = 1.0 / 6227020800.0;
    p = __builtin_fma(p, r, 1.0 / 479001600.0); p = __builtin_fma(p, r, 1.0 / 39916800.0); p = __builtin_fma(p, r, 1.0 / 3628800.0); p = __builtin_fma(p, r, 1.0 / 362880.0); p = __builtin_fma(p, r, 1.0 / 40320.0);
    p = __builtin_fma(p, r, 1.0 / 5040.0); p = __builtin_fma(p, r, 1.0 / 720.0); p = __builtin_fma(p, r, 1.0 / 120.0); p = __builtin_fma(p, r, 1.0 / 24.0); p = __builtin_fma(p, r, 1.0 / 6.0);
    p = __builtin_fma(p, r, 0.5); p = __builtin_fma(p, r, 1.0); p = __builtin_fma(p, r, 1.0);
    const long long bits = ((long long)n + 1023ll) << 52;
    return p * __builtin_bit_cast(double, bits);
}

__device__ __forceinline__ int map_col(int mode, int j) {
    const int pn = j >> 8, bj = (j >> 7) & 1, jj = j & 127;
    if (mode == 1) return bj * 2816 + 128 * pn + jj;
    if (mode == 2) return bj * 1024 + 128 * pn + jj;
    if (mode == 3 || (mode == 4 && pn < 4)) return 64 * (4 * pn + (jj >> 5)) + 32 * bj + (jj & 31);
    return j;
}
__device__ __forceinline__ void p0_transpose_item(const float* W, int K, int ldw, int N, int mode, bf16* WT, LAS float* scr, int item, int lane) {
    const int nblk = N / 32, kb = item / nblk, nb = item % nblk, k0 = 64 * kb, n0 = 32 * nb, s0 = map_col(mode, n0);
#pragma unroll 8
    for (int i = 0; i < 32; ++i) { const int kk = 2 * i + (lane >> 5); scr[kk * 33 + (lane & 31)] = W[(size_t)(k0 + kk) * ldw + s0 + (lane & 31)]; }
    LDS_WAIT(); asm volatile("" ::: "memory");
    const int c = lane & 7;
#pragma unroll
    for (int j = 0; j < 4; ++j) { const int n = (lane >> 3) + 8 * j; const LAS float* s = scr + (8 * c) * 33 + n;
        v4u o; o.x = pk2(s[0 * 33], s[1 * 33]); o.y = pk2(s[2 * 33], s[3 * 33]); o.z = pk2(s[4 * 33], s[5 * 33]); o.w = pk2(s[6 * 33], s[7 * 33]);
        *(GAS v4u*)(WT + (size_t)(n0 + n) * K + k0 + 8 * c) = o; }
    LDS_WAIT(); asm volatile("" ::: "memory");
}
__device__ __forceinline__ void cvt_stream(const float* src, bf16* dst, size_t n8, size_t blk, size_t gap, size_t gt, size_t ngt) {
    for (size_t i = gt; i < n8; i += ngt) {
        const size_t e = i * 8; const f32x4 a = *(const GAS f32x4*)(src + e), b = *(const GAS f32x4*)(src + e + 4);
        v4u o; o.x = pk2(a.x, a.y); o.y = pk2(a.z, a.w); o.z = pk2(b.x, b.y); o.w = pk2(b.z, b.w);
        *(GAS v4u*)(dst + e + (gap ? (e / blk) * gap : 0)) = o;
    }
}
__device__ __forceinline__ void cache_cvt_part(const float* ck, const float* cv, unsigned char* ws, size_t lo, size_t hi, size_t thr, size_t nthr) {
    constexpr size_t N8 = (size_t)NSTREAM_S * PAST * 1024 / 8, BLK = (size_t)PAST * 1024, GAP = (size_t)SEQ_S * 1024;
    for (size_t i = lo + thr; i < hi; i += nthr) {
        const bool isv = i >= N8; const size_t e = (isv ? i - N8 : i) * 8; const float* src = (isv ? cv : ck) + e;
        const f32x4 a = __builtin_nontemporal_load((const GAS f32x4*)src), b = __builtin_nontemporal_load((const GAS f32x4*)(src + 4));
        v4u o; o.x = pk2(a.x, a.y); o.y = pk2(a.z, a.w); o.z = pk2(b.x, b.y); o.w = pk2(b.z, b.w);
        *(GAS v4u*)((bf16*)(ws + (isv ? WS_VC : WS_KC)) + e + (e / BLK) * GAP) = o;
    }
}
struct P0Args { const float *xp, *xs, *ck, *cv, *win, *wout, *wglu, *wq, *wkv, *wo, *a_re, *a_im, *log_dt, *b_re, *b_im; unsigned char* ws; };
__device__ __forceinline__ void p0_prologue(const P0Args& A, LAS unsigned char* lds, int vcu, int G, int wave, int lane) {
    LAS float* scr = (LAS float*)(lds + wave * 16384);
    const int gw = vcu * NWAVES + wave, NGW = G * NWAVES;
    unsigned char* ws = A.ws;
    constexpr int I_IN = 16 * 176, I_OUT = 44 * 32, I_GLU = 16 * 64, I_Q = 16 * 32, I_KV = 16 * 64, I_O = 16 * 32;
    constexpr int NITEMS = 4 * I_IN + 4 * I_OUT + I_GLU + I_Q + I_KV + I_O;
    for (int it = gw; it < NITEMS; it += NGW) {
        int r = it;
        if (r < 4 * I_IN) { const int w = r / I_IN; p0_transpose_item(A.win + (size_t)w * 1024 * 5632, 1024, 5632, 5632, 1, (bf16*)(ws + WS_WIN + w * WIN_BYTES), scr, r % I_IN, lane); continue; } r -= 4 * I_IN;
        if (r < 4 * I_OUT) { const int w = r / I_OUT; p0_transpose_item(A.wout + (size_t)w * 2816 * 1024, 2816, 1024, 1024, 0, (bf16*)(ws + WS_WOUT + w * WOUT_BYTES), scr, r % I_OUT, lane); continue; } r -= 4 * I_OUT;
        if (r < I_GLU) { p0_transpose_item(A.wglu, 1024, 2048, 2048, 2, (bf16*)(ws + WS_WGLU), scr, r, lane); continue; } r -= I_GLU;
        if (r < I_Q) { p0_transpose_item(A.wq, 1024, 1024, 1024, 3, (bf16*)(ws + WS_WQ), scr, r, lane); continue; } r -= I_Q;
        if (r < I_KV) { p0_transpose_item(A.wkv, 1024, 2048, 2048, 4, (bf16*)(ws + WS_WKV), scr, r, lane); continue; } r -= I_KV;
        p0_transpose_item(A.wo, 1024, 1024, 1024, 0, (bf16*)(ws + WS_WO), scr, r, lane);
    }
    const size_t gt = (size_t)gw * 64 + lane, ngt = (size_t)NGW * 64;
    for (size_t it = gt; it < (size_t)KCL * 32; it += ngt) {
        const int pos = (int)(it >> 5), i = (int)(it & 31);
        double th = 1.0; for (int k = 0; k < i; ++k) th *= 0.74989420933245582730;
        double s, c; dsincos((double)pos * th, s, c);
        ((float*)(ws + WS_RC))[it] = (float)c; ((float*)(ws + WS_RS))[it] = (float)s;
    }
    for (size_t it = gt; it < 4096; it += ngt) {
        const int g = (int)(it >> 6);
        const double lre = fmin((double)A.a_re[it], -1e-4), lim = (double)A.a_im[it], dt = dexp((double)A.log_dt[g]);
        const double mag = dexp(lre * dt); double sn, cs; dsincos(fabs(lim * dt), sn, cs); if (lim < 0.0) sn = -sn;
        const double lbr = mag * cs, lbi = mag * sn, den = lre * lre + lim * lim, nre = lbr - 1.0;
        const double cre = (nre * lre + lbi * lim) / den, cim = (lbi * lre - nre * lim) / den;
        float* lb = (float*)(ws + WS_S5); lb[2 * it] = (float)lbr; lb[2 * it + 1] = (float)lbi;
        float* bb = (float*)(ws + WS_S5) + 8192 + it * 32;
        for (int c = 0; c < 16; ++c) { const double br = A.b_re[it * 16 + c], bi = A.b_im[it * 16 + c]; bb[c] = (float)(cre * br - cim * bi); bb[16 + c] = (float)(cre * bi + cim * br); }
    }
    cvt_stream(A.xp, (bf16*)(ws + WS_XB), (size_t)MP * 1024 / 8, 1, 0, gt, ngt);
    cvt_stream(A.xs, (bf16*)(ws + WS_XB) + (size_t)MP * 1024, (size_t)MS * 1024 / 8, 1, 0, gt, ngt);
}

__device__ __forceinline__ void ln_phase(const bf16* T, const float* g, const float* b, bf16* Xo, float* Yo, int gw, int NGW, int lane) {
    constexpr int RB = 4;
    float gv[16], bv[16];
#pragma unroll
    for (int j = 0; j < 2; ++j)
#pragma unroll
        for (int i = 0; i < 8; ++i) { gv[8 * j + i] = g[512 * j + 8 * lane + i]; bv[8 * j + i] = b[512 * j + 8 * lane + i]; }
    for (int rbase = gw * RB; rbase < MT; rbase += NGW * RB) {
        v4u t0[RB], t1[RB];
#pragma unroll
        for (int k = 0; k < RB; ++k) { const int row = (rbase + k < MT) ? rbase + k : MT - 1; const bf16* tp = T + (size_t)row * 1024 + 8 * lane; t0[k] = *(const GAS v4u*)tp; t1[k] = *(const GAS v4u*)(tp + 512); }
#pragma unroll
        for (int k = 0; k < RB; ++k) {
            const int row = rbase + k; if (row >= MT) break;
            float v[16];
            v[0] = bflo(t0[k].x); v[1] = bfhi(t0[k].x); v[2] = bflo(t0[k].y); v[3] = bfhi(t0[k].y); v[4] = bflo(t0[k].z); v[5] = bfhi(t0[k].z); v[6] = bflo(t0[k].w); v[7] = bfhi(t0[k].w);
            v[8] = bflo(t1[k].x); v[9] = bfhi(t1[k].x); v[10] = bflo(t1[k].y); v[11] = bfhi(t1[k].y); v[12] = bflo(t1[k].z); v[13] = bfhi(t1[k].z); v[14] = bflo(t1[k].w); v[15] = bfhi(t1[k].w);
            float s = 0.f;
#pragma unroll
            for (int i = 0; i < 16; ++i) s += v[i];
            const float mean = wave_sum(s) * (1.f / 1024.f); float s2 = 0.f;
#pragma unroll
            for (int i = 0; i < 16; ++i) { v[i] -= mean; s2 += v[i] * v[i]; }
            const float rstd = 1.f / sqrtf(wave_sum(s2) * (1.f / 1024.f) + LN_EPSF);
#pragma unroll
            for (int i = 0; i < 16; ++i) v[i] = v[i] * rstd * gv[i] + bv[i];
            if (Yo) {
                float* yp = Yo + (size_t)row * 1024 + 8 * lane;
                *(GAS f32x4*)yp = (f32x4){v[0], v[1], v[2], v[3]}; *(GAS f32x4*)(yp + 4) = (f32x4){v[4], v[5], v[6], v[7]};
                *(GAS f32x4*)(yp + 512) = (f32x4){v[8], v[9], v[10], v[11]}; *(GAS f32x4*)(yp + 516) = (f32x4){v[12], v[13], v[14], v[15]};
            } else {
                bf16* xp = Xo + (size_t)row * 1024 + 8 * lane;
                v4u o; o.x = pk2(v[0], v[1]); o.y = pk2(v[2], v[3]); o.z = pk2(v[4], v[5]); o.w = pk2(v[6], v[7]); *(GAS v4u*)xp = o;
                o.x = pk2(v[8], v[9]); o.y = pk2(v[10], v[11]); o.z = pk2(v[12], v[13]); o.w = pk2(v[14], v[15]); *(GAS v4u*)(xp + 512) = o;
            }
        }
    }
}

__device__ __forceinline__ void combine_phase(bf16* O1, const bf16* O2, const float* lamv, const float* subg, int gw, int NGW, int lane) {
    constexpr int RB = 4;
    const float lam = expf(wave_sum(lamv[lane] * lamv[64 + lane])) - expf(wave_sum(lamv[128 + lane] * lamv[192 + lane])) + LAM_INIT;
    float gs[16];
#pragma unroll
    for (int i = 0; i < 16; ++i) gs[i] = subg[(lane & 7) * 16 + i] * (1.f - LAM_INIT);
    for (int rbase = gw * RB; rbase < MT; rbase += NGW * RB) {
        v4u a0[RB], a1[RB], b0[RB], b1[RB];
#pragma unroll
        for (int k = 0; k < RB; ++k) { const int row = (rbase + k < MT) ? rbase + k : MT - 1; const bf16* p1 = O1 + (size_t)row * 1024 + 16 * lane; const bf16* p2 = O2 + (size_t)row * 1024 + 16 * lane;
            a0[k] = *(const GAS v4u*)p1; a1[k] = *(const GAS v4u*)(p1 + 8); b0[k] = *(const GAS v4u*)p2; b1[k] = *(const GAS v4u*)(p2 + 8); }
#pragma unroll
        for (int k = 0; k < RB; ++k) {
            const int row = rbase + k; if (row >= MT) break;
            float v[16];
            v[0] = bflo(a0[k].x) - lam * bflo(b0[k].x); v[1] = bfhi(a0[k].x) - lam * bfhi(b0[k].x); v[2] = bflo(a0[k].y) - lam * bflo(b0[k].y); v[3] = bfhi(a0[k].y) - lam * bfhi(b0[k].y);
            v[4] = bflo(a0[k].z) - lam * bflo(b0[k].z); v[5] = bfhi(a0[k].z) - lam * bfhi(b0[k].z); v[6] = bflo(a0[k].w) - lam * bflo(b0[k].w); v[7] = bfhi(a0[k].w) - lam * bfhi(b0[k].w);
            v[8] = bflo(a1[k].x) - lam * bflo(b1[k].x); v[9] = bfhi(a1[k].x) - lam * bfhi(b1[k].x); v[10] = bflo(a1[k].y) - lam * bflo(b1[k].y); v[11] = bfhi(a1[k].y) - lam * bfhi(b1[k].y);
            v[12] = bflo(a1[k].z) - lam * bflo(b1[k].z); v[13] = bfhi(a1[k].z) - lam * bfhi(b1[k].z); v[14] = bflo(a1[k].w) - lam * bflo(b1[k].w); v[15] = bfhi(a1[k].w) - lam * bfhi(b1[k].w);
            float ss = 0.f;
#pragma unroll
            for (int i = 0; i < 16; ++i) ss += v[i] * v[i];
            ss += __shfl_xor(ss, 1); ss += __shfl_xor(ss, 2); ss += __shfl_xor(ss, 4);
            const float r = 1.f / sqrtf(ss * (1.f / 128.f) + RMS_EPSF);
#pragma unroll
            for (int i = 0; i < 16; ++i) v[i] = v[i] * r * gs[i];
            bf16* p1 = O1 + (size_t)row * 1024 + 16 * lane;
            v4u o; o.x = pk2(v[0], v[1]); o.y = pk2(v[2], v[3]); o.z = pk2(v[4], v[5]); o.w = pk2(v[6], v[7]); *(GAS v4u*)p1 = o;
            o.x = pk2(v[8], v[9]); o.y = pk2(v[10], v[11]); o.z = pk2(v[12], v[13]); o.w = pk2(v[14], v[15]); *(GAS v4u*)(p1 + 8) = o;
        }
    }
}

__device__ __forceinline__ float gelu_tanh(float x) { const float t = 1.5957691216057308f * (x + 0.044715f * x * x * x); return x * __builtin_amdgcn_rcpf(1.f + __builtin_amdgcn_exp2f(-1.4426950408889634f * t)); }
struct S5Args { const bf16* XB; bf16* ZB; const float* s5p; const float *c_re, *c_im, *dsk, *st_re, *st_im; float* out; };
__device__ __forceinline__ void s5_valu_phase(const S5Args& A, LAS float* ybuf, int gw, int NGW, int lane) {
    for (int pass = 0; pass < 2; ++pass)
    for (int wu = gw; wu < 2048; wu += NGW) {
        const int stream = wu >> 6, g = wu & 63, nch = pass == 0 ? 32 : 1, gp = g * 64 + lane;
        const size_t row0 = pass == 0 ? (size_t)stream * 2048 : (size_t)MP + (size_t)stream * 64;
        const float lbr = A.s5p[2 * gp], lbi = A.s5p[2 * gp + 1];
        float bbr[16], bbi[16], cr[16], ci[16], dk[16];
#pragma unroll
        for (int c = 0; c < 16; ++c) { bbr[c] = A.s5p[8192 + gp * 32 + c]; bbi[c] = A.s5p[8192 + gp * 32 + 16 + c]; cr[c] = A.c_re[(g * 16 + c) * 64 + lane]; ci[c] = A.c_im[(g * 16 + c) * 64 + lane]; dk[c] = A.dsk[g * 16 + c]; }
        float hr = 0.f, hi = 0.f;
        if (pass == 1) { hr = A.st_re[(stream * 64 + g) * 64 + lane]; hi = A.st_im[(stream * 64 + g) * 64 + lane]; }
        const bf16* xp = A.XB + (row0 + lane) * 1024 + g * 16;
        v4u w0 = *(const GAS v4u*)xp, w1 = *(const GAS v4u*)(xp + 8);
        for (int ch = 0; ch < nch; ++ch) {
            v4u n0 = w0, n1 = w1;
            if (ch + 1 < nch) { n0 = *(const GAS v4u*)(xp + (size_t)(ch + 1) * 65536); n1 = *(const GAS v4u*)(xp + (size_t)(ch + 1) * 65536 + 8); }
#pragma unroll 2
            for (int t = 0; t < 64; ++t) {
                unsigned sw[8];
                sw[0] = __builtin_amdgcn_readlane(w0.x, t); sw[1] = __builtin_amdgcn_readlane(w0.y, t); sw[2] = __builtin_amdgcn_readlane(w0.z, t); sw[3] = __builtin_amdgcn_readlane(w0.w, t);
                sw[4] = __builtin_amdgcn_readlane(w1.x, t); sw[5] = __builtin_amdgcn_readlane(w1.y, t); sw[6] = __builtin_amdgcn_readlane(w1.z, t); sw[7] = __builtin_amdgcn_readlane(w1.w, t);
                float bur = 0.f, bui = 0.f;
#pragma unroll
                for (int k = 0; k < 8; ++k) { const float u0 = bflo(sw[k]), u1 = bfhi(sw[k]); bur += bbr[2 * k] * u0; bui += bbi[2 * k] * u0; bur += bbr[2 * k + 1] * u1; bui += bbi[2 * k + 1] * u1; }
                const float nr = lbr * hr - lbi * hi + bur, ni = lbr * hi + lbi * hr + bui; hr = nr; hi = ni;
                float v[16];
#pragma unroll
                for (int c = 0; c < 16; ++c) v[c] = cr[c] * hr - ci[c] * hi;
                float v8[8], v4[4], v2[2];
#pragma unroll
                for (int i = 0; i < 8; ++i) { const bool up = lane >= 32; const float keep = up ? v[i + 8] : v[i], send = up ? v[i] : v[i + 8]; v8[i] = keep + __shfl_xor(send, 32); }
#pragma unroll
                for (int i = 0; i < 4; ++i) { const bool up = (lane & 16) != 0; const float keep = up ? v8[i + 4] : v8[i], send = up ? v8[i] : v8[i + 4]; v4[i] = keep + __shfl_xor(send, 16); }
#pragma unroll
                for (int i = 0; i < 2; ++i) { const bool up = (lane & 8) != 0; const float keep = up ? v4[i + 2] : v4[i], send = up ? v4[i] : v4[i + 2]; v2[i] = keep + __shfl_xor(send, 8); }
                float y; { const bool up = (lane & 4) != 0; const float keep = up ? v2[1] : v2[0], send = up ? v2[0] : v2[1]; y = keep + __shfl_xor(send, 4); }
                y += __shfl_xor(y, 2); y += __shfl_xor(y, 1);
                if ((lane & 3) == 0) ybuf[t * 17 + (lane >> 2)] = y;
            }
            LDS_WAIT(); asm volatile("" ::: "memory");
            {
                float z[16];
                const unsigned ww[8] = {w0.x, w0.y, w0.z, w0.w, w1.x, w1.y, w1.z, w1.w};
#pragma unroll
                for (int k = 0; k < 8; ++k) { z[2 * k] = gelu_tanh(ybuf[lane * 17 + 2 * k] + dk[2 * k] * bflo(ww[k])); z[2 * k + 1] = gelu_tanh(ybuf[lane * 17 + 2 * k + 1] + dk[2 * k + 1] * bfhi(ww[k])); }
                bf16* zp = A.ZB + (row0 + (size_t)ch * 64 + lane) * 1024 + g * 16;
                v4u o; o.x = pk2(z[0], z[1]); o.y = pk2(z[2], z[3]); o.z = pk2(z[4], z[5]); o.w = pk2(z[6], z[7]); *(GAS v4u*)zp = o;
                o.x = pk2(z[8], z[9]); o.y = pk2(z[10], z[11]); o.z = pk2(z[12], z[13]); o.w = pk2(z[14], z[15]); *(GAS v4u*)(zp + 8) = o;
            }
            LDS_WAIT(); asm volatile("" ::: "memory");
            w0 = n0; w1 = n1;
        }
        float* ore = A.out + (pass == 0 ? O_PSR : O_SSR) + (size_t)(stream * 64 + g) * 64 + lane;
        ore[0] = hr; ore[131072] = hi;
    }
}
typedef short s5_bf16x8 __attribute__((ext_vector_type(8)));
typedef float s5_f32x16 __attribute__((ext_vector_type(16)));
__device__ __forceinline__ int s5_crow(int r, int hi) { return (r & 3) + 8 * (r >> 2) + 4 * hi; }
constexpr int S5_RS = 272, S5_WAVE_LDS = 32 * S5_RS;
__device__ __forceinline__ void s5_mfma_phase(const S5Args& A, LAS unsigned char* hs, int gw, int NGW, int lane) {
    const int p32 = lane & 31, hi = lane >> 5;
    for (int pass = 0; pass < 2; ++pass)
    for (int wu = gw; wu < 2048; wu += NGW) {
        const int stream = wu >> 6, g = wu & 63, nsub = pass == 0 ? 64 : 2;
        const size_t row0 = pass == 0 ? (size_t)stream * 2048 : (size_t)MP + (size_t)stream * 64;
        s5_bf16x8 bre[2], bim[2]; float L[2][4][2]; float h[2][2];
#pragma unroll
        for (int pb = 0; pb < 2; ++pb) {
            const int gp = g * 64 + 32 * pb + p32; const float* bb = A.s5p + 8192 + gp * 32;
#pragma unroll
            for (int k = 0; k < 8; ++k) { const int c = 4 * hi + (k & 3) + 8 * (k >> 2); bre[pb][k] = (short)f2bf(bb[c]); bim[pb][k] = (short)f2bf(bb[16 + c]); }
            const float lr = A.s5p[2 * gp], li = A.s5p[2 * gp + 1];
            L[pb][0][0] = lr; L[pb][0][1] = li;
            L[pb][1][0] = lr * lr - li * li; L[pb][1][1] = 2.f * lr * li;
            L[pb][2][0] = L[pb][1][0] * lr - L[pb][1][1] * li; L[pb][2][1] = L[pb][1][0] * li + L[pb][1][1] * lr;
            L[pb][3][0] = L[pb][1][0] * L[pb][1][0] - L[pb][1][1] * L[pb][1][1]; L[pb][3][1] = 2.f * L[pb][1][0] * L[pb][1][1];
            h[pb][0] = 0.f; h[pb][1] = 0.f;
            if (pass == 1) { h[pb][0] = A.st_re[(stream * 64 + g) * 64 + 32 * pb + p32]; h[pb][1] = A.st_im[(stream * 64 + g) * 64 + 32 * pb + p32]; }
        }
        s5_bf16x8 cm[8];
#pragma unroll
        for (int kb = 0; kb < 8; ++kb)
#pragma unroll
            for (int k = 0; k < 8; ++k) { const int p = 8 * kb + 4 * hi + (k >> 1); const int ci = (g * 16 + (p32 & 15)) * 64 + p;
                const float v = (k & 1) ? -A.c_im[ci] : A.c_re[ci]; cm[kb][k] = (short)(p32 < 16 ? f2bf(v) : 0u); }
        float dk[8];
#pragma unroll
        for (int j = 0; j < 4; ++j) { dk[j] = A.dsk[g * 16 + 4 * hi + j]; dk[4 + j] = A.dsk[g * 16 + 8 + 4 * hi + j]; }
        const bf16* up = A.XB + (row0 + p32) * 1024 + g * 16 + 4 * hi;
        v2u u0 = *(const GAS v2u*)up, u1 = *(const GAS v2u*)(up + 8);
        LAS unsigned* hw = (LAS unsigned*)(hs + hi * 4 * S5_RS + 4 * p32);
        const LAS unsigned char* hr = hs + p32 * S5_RS + 16 * hi;
        for (int sc = 0; sc < nsub; ++sc) {
            v2u n0 = u0, n1 = u1;
            if (sc + 1 < nsub) { n0 = *(const GAS v2u*)(up + (size_t)(sc + 1) * 32768); n1 = *(const GAS v2u*)(up + (size_t)(sc + 1) * 32768 + 8); }
            const v4u uw = {u0.x, u0.y, u1.x, u1.y};
            const s5_bf16x8 ua = __builtin_bit_cast(s5_bf16x8, uw);
            s5_f32x16 xr[2], xi[2];
            const s5_f32x16 z16 = {};
#pragma unroll
            for (int pb = 0; pb < 2; ++pb) { xr[pb] = __builtin_amdgcn_mfma_f32_32x32x16_bf16(ua, bre[pb], z16, 0, 0, 0); xi[pb] = __builtin_amdgcn_mfma_f32_32x32x16_bf16(ua, bim[pb], z16, 0, 0, 0); }
#pragma unroll
            for (int pb = 0; pb < 2; ++pb) {
                const float l1r = L[pb][0][0], l1i = L[pb][0][1], l4r = L[pb][3][0], l4i = L[pb][3][1];
#pragma unroll
                for (int q = 0; q < 4; ++q)
#pragma unroll
                    for (int i = 1; i < 4; ++i) { const float pr = xr[pb][4 * q + i - 1], pi = xi[pb][4 * q + i - 1];
                        xr[pb][4 * q + i] += l1r * pr - l1i * pi; xi[pb][4 * q + i] += l1r * pi + l1i * pr; }
                float cr[9], ci[9]; cr[0] = h[pb][0]; ci[0] = h[pb][1];
#pragma unroll
                for (int q = 0; q < 4; ++q) {
                    const float er = xr[pb][4 * q + 3], ei = xi[pb][4 * q + 3];
                    const auto sr = __builtin_amdgcn_permlane32_swap(__float_as_uint(er), __float_as_uint(er), false, false);
                    const auto si = __builtin_amdgcn_permlane32_swap(__float_as_uint(ei), __float_as_uint(ei), false, false);
                    const float e0r = __uint_as_float(sr[0]), e1r = __uint_as_float(sr[1]), e0i = __uint_as_float(si[0]), e1i = __uint_as_float(si[1]);
                    cr[2 * q + 1] = l4r * cr[2 * q] - l4i * ci[2 * q] + e0r; ci[2 * q + 1] = l4r * ci[2 * q] + l4i * cr[2 * q] + e0i;
                    cr[2 * q + 2] = l4r * cr[2 * q + 1] - l4i * ci[2 * q + 1] + e1r; ci[2 * q + 2] = l4r * ci[2 * q + 1] + l4i * cr[2 * q + 1] + e1i;
                }
                h[pb][0] = cr[8]; h[pb][1] = ci[8];
#pragma unroll
                for (int q = 0; q < 4; ++q) { const float mr = hi ? cr[2 * q + 1] : cr[2 * q], mi = hi ? ci[2 * q + 1] : ci[2 * q];
#pragma unroll
                    for (int i = 0; i < 4; ++i) { xr[pb][4 * q + i] += L[pb][i][0] * mr - L[pb][i][1] * mi; xi[pb][4 * q + i] += L[pb][i][0] * mi + L[pb][i][1] * mr; } }
#pragma unroll
                for (int r = 0; r < 16; ++r) hw[((r & 3) + 8 * (r >> 2)) * (S5_RS / 4) + 32 * pb] = pk2(xr[pb][r], xi[pb][r]);
            }
            s5_f32x16 yt = {};
#pragma unroll
            for (int kb = 0; kb < 8; ++kb) { const s5_bf16x8 hf = *(const LAS s5_bf16x8*)(hr + 32 * kb); yt = __builtin_amdgcn_mfma_f32_32x32x16_bf16(cm[kb], hf, yt, 0, 0, 0); }
            {
                float z[8];
                z[0] = gelu_tanh(yt[0] + dk[0] * bflo(u0.x)); z[1] = gelu_tanh(yt[1] + dk[1] * bfhi(u0.x)); z[2] = gelu_tanh(yt[2] + dk[2] * bflo(u0.y)); z[3] = gelu_tanh(yt[3] + dk[3] * bfhi(u0.y));
                z[4] = gelu_tanh(yt[4] + dk[4] * bflo(u1.x)); z[5] = gelu_tanh(yt[5] + dk[5] * bfhi(u1.x)); z[6] = gelu_tanh(yt[6] + dk[6] * bflo(u1.y)); z[7] = gelu_tanh(yt[7] + dk[7] * bfhi(u1.y));
                bf16* zp = A.ZB + (row0 + (size_t)sc * 32 + p32) * 1024 + g * 16 + 4 * hi;
                v2u o; o.x = pk2(z[0], z[1]); o.y = pk2(z[2], z[3]); *(GAS v2u*)zp = o;
                o.x = pk2(z[4], z[5]); o.y = pk2(z[6], z[7]); *(GAS v2u*)(zp + 8) = o;
            }
            u0 = n0; u1 = n1;
        }
        if (hi == 0) {
            float* ore = A.out + (pass == 0 ? O_PSR : O_SSR) + (size_t)(stream * 64 + g) * 64 + p32;
            ore[0] = h[0][0]; ore[32] = h[1][0]; ore[131072] = h[0][1]; ore[131072 + 32] = h[1][1];
        }
    }
}
__device__ __forceinline__ void attention_phase(char* lds, const bf16* QB, const bf16* KB, const bf16* VB, const bf16* KC, const bf16* VC, bf16* O1, bf16* O2, int vcu, int G) {
    typedef attn_body::bf16 abf;
    const int wid = __builtin_amdgcn_readfirstlane((int)(threadIdx.x >> 6)), wm = wid >> 2, wv = (wid >> 1) & 1, qh = wid & 1;
    const int ngrp = G / 32;
    for (int grp = vcu / 32; grp < 8; grp += ngrp) {
        const int c = vcu % 32;
        for (int s = 0; s < 33; ++s) {
            const bool smp = (s == c); const int i = s - (s > c ? 1 : 0);
            const int bh = grp * 32 + (smp ? c : i), b = bh >> 3, h = bh & 7, j = (i & 1) ? 31 - c : c;
            const size_t qrow = smp ? (size_t)MP + (size_t)b * SEQ_S + 32 * qh : (size_t)b * SEQ_P + 64 * j + 32 * qh;
            const size_t krow = smp ? (size_t)b * KCL : (size_t)b * SEQ_P;
            const bf16* Kh = (smp ? KC : KB) + krow * 1024 + h * 128; const bf16* Vh = (smp ? VC : VB) + krow * 1024 + h * 128;
            attn_body::attn_unit<8>((const abf*)(QB + qrow * 1024 + h * 128 + wm * 64), (const abf*)Kh, (const abf*)Vh, (abf*)((wm ? O2 : O1) + qrow * 1024 + h * 128 + wv * 64), smp ? KCL / 64 : j + 1, lds);
        }
    }
}

struct Args { const float* in[24]; float* out; unsigned char* ws; int ph_lo, ph_hi, li, pad; };
__global__ void __launch_bounds__(NWAVES * 64, 2) yoco_fwd(Args args) {
    extern __shared__ __attribute__((aligned(16))) unsigned char lds[];
    LAS unsigned char* const L = (LAS unsigned char*)lds;
    volatile LAS unsigned* MISC = (volatile LAS unsigned*)(L + MISC_OFF);
    const int tid = threadIdx.x, lane = tid & 63, wave = __builtin_amdgcn_readfirstlane(tid >> 6);
    const int G = gridDim.x; const int bx = blockIdx.x; const int vcu = (G % 8 == 0) ? (bx % 8) * (G / 8) + bx / 8 : bx;
    const int gw = vcu * NWAVES + wave, NGW = G * NWAVES;
    unsigned char* ws = args.ws;
    gu32* ctl = (gu32*)(ws + WS_CTL);
    for (int u = tid; u < (LDS_BYTES - LDSCTL_OFF) / 4; u += NWAVES * 64) ((LAS unsigned*)(L + LDSCTL_OFF))[u] = 0u;
    __syncthreads();
    XcdBarrier bar; bar.bar = (unsigned*)(ctl + CW_BAR); bar.x = 0; bar.st = nullptr;
#if MK_ONE_LAUNCH
    bar = xcd_barrier_post((unsigned*)(ctl + CW_BAR), MISC + 8);
#endif
    const int lo = args.ph_lo, hi = args.ph_hi;
#ifndef PHMASK
#define PHMASK 0xffffffffu
#endif
#define IN(k) (((PHMASK >> (k)) & 1u) && lo <= (k) && (k) < hi)
#define SEAM(k) do { if (IN(k) && IN((k) + 1)) xcd_barrier(bar); } while (0)
    const float *x_prompt = args.in[0], *x_sample = args.in[1], *cache_k = args.in[2], *cache_v = args.in[3], *st_re = args.in[4], *st_im = args.in[5], *ln_g = args.in[6], *ln_b = args.in[7],
                *ffn_w_in = args.in[8], *ffn_w_out = args.in[9], *a_re = args.in[10], *a_im = args.in[11], *log_dt = args.in[12], *b_re = args.in[13], *b_im = args.in[14], *c_re = args.in[15],
                *c_im = args.in[16], *ssm_d = args.in[17], *w_glu = args.in[18], *w_q = args.in[19], *w_kv = args.in[20], *attn_lam = args.in[21], *subln_g = args.in[22], *w_o = args.in[23];
    float* out = args.out;
    bf16* XB = (bf16*)(ws + WS_XB); bf16* TB = (bf16*)(ws + WS_TB); bf16* HB = (bf16*)(ws + WS_HB); bf16* ZB = (bf16*)(ws + WS_ZB); bf16* QB = (bf16*)(ws + WS_QB); bf16* O2 = (bf16*)(ws + WS_O2);
    bf16* KB = (bf16*)(ws + WS_KB); bf16* VB = (bf16*)(ws + WS_VB); bf16* KC = (bf16*)(ws + WS_KC); bf16* VC = (bf16*)(ws + WS_VC);
    const float* RC = (const float*)(ws + WS_RC); const float* RS = (const float*)(ws + WS_RS);
#define WIN(i) ((const bf16*)(ws + WS_WIN + (size_t)(i) * WIN_BYTES))
#define WOUT(i) ((const bf16*)(ws + WS_WOUT + (size_t)(i) * WOUT_BYTES))
#define FFN_UP(i) do { pg8::Gemm g{XB, WIN(i), MT, 2 * DFF, DMODEL}; pg8::StaticOrder S; S.init(MT, 2 * DFF, G, bx); pg8::EpiSwiglu E{HB, DFF}; \
        pg8::gemm_phase<pg8::EpiSwiglu, pg8::StaticOrder, true, true>(L, g, S, E); } while (0)
#define FFN_DOWN(i) do { pg8::Gemm g{HB, WOUT(i), MT, DMODEL, DFF}; pg8::StaticOrder S; S.init(MT, DMODEL, G, bx); pg8::EpiResid E{XB, TB, 0.5f}; \
        pg8::gemm_phase<pg8::EpiResid, pg8::StaticOrder, true, true>(L, g, S, E); } while (0)
    constexpr size_t CC_N = 2 * (size_t)NSTREAM_S * PAST * 1024 / 8;
#define CACHE_PART(f0, f1) CACHE_PART_N(1056, f0, f1)
#define CACHE_PART_N(nwg, f0, f1) do { const int ntail = (nwg) % G; if (bx >= ntail && G > ntail) cache_cvt_part(cache_k, cache_v, ws, (size_t)(CC_N * (f0)), (size_t)(CC_N * (f1)), (size_t)(bx - ntail) * 512 + tid, (size_t)(G - ntail) * 512); } while (0)
#define LNORM(i, Yo) ln_phase(TB, ln_g + (i) * 1024, ln_b + (i) * 1024, XB, (Yo), gw, NGW, lane)

    if (IN(0)) { P0Args A{x_prompt, x_sample, cache_k, cache_v, ffn_w_in, ffn_w_out, w_glu, w_q, w_kv, w_o, a_re, a_im, log_dt, b_re, b_im, ws}; p0_prologue(A, L, vcu, G, wave, lane);
#if defined(PROBE_PRO2)
        __syncthreads(); p0_prologue(A, L, vcu, G, wave, lane);
#endif
    } SEAM(0);
    if (IN(1)) { FFN_UP(0);
#if defined(PROBE_UP2)
        FFN_UP(0);
#endif
    } SEAM(1);
    if (IN(2)) { FFN_DOWN(0); CACHE_PART(0.0, 0.27);
#if defined(PROBE_DOWN2)
        FFN_DOWN(0);
#endif
    } SEAM(2);
    if (IN(3)) { LNORM(0, nullptr);
#if defined(PROBE_LN2)
        LNORM(0, nullptr);
#endif
    } SEAM(3);
    if (IN(4)) { S5Args A{XB, ZB, (const float*)(ws + WS_S5), c_re, c_im, ssm_d, st_re, st_im, out};
#if defined(S5_VALU)
                 s5_valu_phase(A, (LAS float*)(L + wave * 4352), gw, NGW, lane);
#else
                 s5_mfma_phase(A, L + wave * S5_WAVE_LDS, gw, NGW, lane);
#endif
#if defined(PROBE_S52)
                 s5_mfma_phase(A, L + wave * S5_WAVE_LDS, gw, NGW, lane);
#endif
 } SEAM(4);
    if (IN(5)) { pg8::Gemm g{ZB, (const bf16*)(ws + WS_WGLU), MT, 2048, DMODEL}; pg8::StaticOrder S; S.init(MT, 2048, G, bx); pg8::EpiGlu E{XB, TB};
                 pg8::gemm_phase<pg8::EpiGlu, pg8::StaticOrder, true, true>(L, g, S, E); CACHE_PART_N(2112, 0.27, 0.36); } SEAM(5);
    if (IN(6)) { LNORM(1, nullptr); } SEAM(6);
    if (IN(7)) { FFN_UP(1); } SEAM(7);
    if (IN(8)) { FFN_DOWN(1); CACHE_PART(0.36, 0.63); } SEAM(8);
    if (IN(9)) { LNORM(2, nullptr); } SEAM(9);
    if (IN(10)) { pg8::Gemm g{XB, (const bf16*)(ws + WS_WKV), MT, 2048, DMODEL}; pg8::StaticOrder S; S.init(MT, 2048, G, G - 1 - bx);
                  pg8::EpiKV E{KB, VB, KC, VC, out + O_PK, out + O_PV, out + O_SK, out + O_SV, RC, RS};
                  pg8::gemm_phase<pg8::EpiKV, pg8::StaticOrder, true, true>(L, g, S, E); }
    if (IN(10)) { FFN_UP(2); } SEAM(11);
    if (IN(12)) { FFN_DOWN(2); CACHE_PART(0.63, 0.90); } SEAM(12);
    if (IN(13)) { LNORM(3, nullptr); } SEAM(13);
    if (IN(14)) { pg8::Gemm g{XB, (const bf16*)(ws + WS_WQ), MT, DMODEL, DMODEL}; pg8::StaticOrder S; S.init(MT, DMODEL, G, bx); pg8::EpiQ E{QB, RC, RS, attn_body::C2};
                  pg8::gemm_phase<pg8::EpiQ, pg8::StaticOrder, true, true>(L, g, S, E); CACHE_PART(0.90, 1.0); } SEAM(14);
    if (IN(15)) {
#if defined(PROBE_ATTN2)
        attention_phase((char*)lds, QB, KB, VB, KC, VC, TB, TB, vcu, G);
#endif
        attention_phase((char*)lds, QB, KB, VB, KC, VC, QB, O2, vcu, G); } SEAM(15);
    if (IN(16)) { combine_phase(QB, O2, attn_lam, subln_g, gw, NGW, lane); } SEAM(16);
    if (IN(17)) { pg8::Gemm g{QB, (const bf16*)(ws + WS_WO), MT, DMODEL, DMODEL}; pg8::StaticOrder S; S.init(MT, DMODEL, G, bx); pg8::EpiResid E{XB, TB, 1.0f};
                  pg8::gemm_phase<pg8::EpiResid, pg8::StaticOrder, true, true>(L, g, S, E); } SEAM(17);
    if (IN(18)) { LNORM(4, nullptr); } SEAM(18);
    if (IN(19)) { FFN_UP(3); } SEAM(19);
    if (IN(20)) { FFN_DOWN(3); } SEAM(20);
    if (IN(21)) { LNORM(5, out + O_Y); }
#undef IN
#undef SEAM
}

extern "C" void kernel_launch(void* const* d_in, const int* in_sizes, int n_in, void* d_out, int out_size, void* d_ws, size_t ws_size, hipStream_t stream) {
    static int grid = 0;
    if (grid == 0) {
        if (n_in != 24 || (size_t)out_size != O_END || ws_size < WS_END) { fprintf(stderr, "kernel_launch: unexpected problem shape (n_in %d, out %d, ws %zu < %zu); nothing launched\n", n_in, out_size, ws_size, (size_t)WS_END); grid = -1; return; }
        int dev = 0, cus = 0, per_cu = 0;
        if (hipGetDevice(&dev) != hipSuccess || hipDeviceGetAttribute(&cus, hipDeviceAttributeMultiprocessorCount, dev) != hipSuccess) { grid = -1; return; }
        if (hipFuncSetAttribute((const void*)yoco_fwd, hipFuncAttributeMaxDynamicSharedMemorySize, LDS_BYTES) != hipSuccess) { fprintf(stderr, "kernel_launch: hipFuncSetAttribute failed\n"); grid = -1; return; }
        if (hipOccupancyMaxActiveBlocksPerMultiprocessor(&per_cu, (const void*)yoco_fwd, NWAVES * 64, LDS_BYTES) != hipSuccess || per_cu < 1) { fprintf(stderr, "kernel_launch: occupancy query reports %d blocks per CU\n", per_cu); }
        (void)hipGetLastError();
        grid = (cus / 32) * 32; if (grid < 32) grid = 32;
    }
    if (grid < 0) return;
    if (hipMemsetAsync((char*)d_ws + WS_CTL, 0, CTL_ZERO_BYTES, stream) != hipSuccess) return;
    Args a{};
    for (int i = 0; i < 24; ++i) a.in[i] = (const float*)d_in[i];
    a.out = (float*)d_out; a.ws = (unsigned char*)d_ws; a.pad = 0;
#if MK_ONE_LAUNCH
    a.ph_lo = 0; a.ph_hi = NPHASE; a.li = 0;
    hipLaunchKernelGGL(yoco_fwd, dim3(grid), dim3(NWAVES * 64), LDS_BYTES, stream, a);
#else
    for (int p = 0; p < NPHASE; ++p) { a.ph_lo = p; a.ph_hi = p + 1; a.li = p; hipLaunchKernelGGL(yoco_fwd, dim3(grid), dim3(NWAVES * 64), LDS_BYTES, stream, a); }
#endif
}
```

```cpp
#include <hip/hip_runtime.h>
#include <hip/hip_bf16.h>
#include <cstdio>
#include <cstdint>
#include <cmath>
#ifndef MK_ONE_LAUNCH
#define MK_ONE_LAUNCH 1
#endif
namespace pg8 {
#define PG8_LAS __attribute__((address_space(3)))
typedef unsigned short bf16_t;
typedef short bf16x8 __attribute__((ext_vector_type(8)));
typedef float f32x4 __attribute__((ext_vector_type(4)));
typedef unsigned u32x4 __attribute__((ext_vector_type(4)));
constexpr int BM = 256, BK = 64, HALF = 128, HTB = HALF * BK * 2  , STAGE_BYTES = 8 * HTB, NXCD = 8, WGM = 8;

__host__ __device__ __forceinline__ int lds_byte(int r, int c) { const int st = (r >> 4) * 2 + (c >> 5), rr = r & 15, cc = c & 31, ob = rr * 64 + cc * 2; return st * 1024 + (ob ^ (((ob >> 9) & 1) << 5)); }
__host__ __device__ __forceinline__ void stage_rc(int b, int& R, int& C) { const int st = b / 1024, sb = b % 1024, swz = sb ^ (((sb >> 9) & 1) << 5); R = (st >> 1) * 16 + swz / 64; C = (st & 1) * 32 + (swz % 64) / 2; }
__host__ __device__ __forceinline__ int perm32(int rho) { const int n = rho >> 4, i = rho & 15; return 8 * (i >> 2) + 4 * n + (i & 3); }

struct Unit { int pm, pn; };
struct Gemm { const bf16_t* A; const bf16_t* Bt; int M, N, K; };

struct StaticOrder {
    int nM, nN, nwg, G, c;
    __host__ __device__ void init(int M, int N, int G_, int c_) { nM = M / BM; nN = N / BM; nwg = nM * nN; G = G_; c = c_; }
    __host__ __device__ bool next(int i, Unit& u) const {
        const long L = (long)i * G + c; if (L >= nwg) return false;
        int wgid = (int)L; { const int q = nwg / NXCD, r = nwg % NXCD, xcd = wgid % NXCD, off = wgid / NXCD; wgid = (xcd < r ? xcd * (q + 1) : r * (q + 1) + (xcd - r) * q) + off; }
        const int nig = WGM * nN, gid = wgid / nig, fm = gid * WGM, gsz = (nM - fm) < WGM ? (nM - fm) : WGM;
        u.pm = fm + ((wgid % nig) % gsz); u.pn = (wgid % nig) / gsz; return true;
    }
    __device__ __forceinline__ void a_ready(const Unit&) const {}
    __device__ __forceinline__ void done(const Unit&) const {}
};

__device__ __forceinline__ unsigned cvt_pk_bf16(float lo, float hi) { unsigned r; asm volatile("v_cvt_pk_bf16_f32 %0, %1, %2" : "=v"(r) : "v"(lo), "v"(hi)); return r; }
typedef float f32x2 __attribute__((ext_vector_type(2)));
__device__ __forceinline__ float bf_lo(unsigned w) { return __uint_as_float(w << 16); }
__device__ __forceinline__ float bf_hi(unsigned w) { return __uint_as_float(w & 0xffff0000u); }
__device__ __forceinline__ float sigm(float a) { return __builtin_amdgcn_rcpf(1.f + __builtin_amdgcn_exp2f(-1.4426950408889634f * a)); }
constexpr float ALPHA_RES = 1.41421356237309515f;

struct EpiSwiglu {
    static constexpr bool PERM = true, AFTER_DRAIN = false;
    bf16_t* H; int ldh;
    __device__ __forceinline__ void operator()(const f32x4 (&acc)[2][2][4][2], const Unit& u, int wr, int wc, int fr, int fq) const {
        const int row0 = u.pm * BM + wr * 64 + fr, col0 = u.pn * HALF + wc * 32 + 8 * fq;
#pragma unroll
        for (int ai = 0; ai < 2; ++ai)
#pragma unroll
            for (int m = 0; m < 4; ++m) {
                float h[8];
#pragma unroll
                for (int n = 0; n < 2; ++n)
#pragma unroll
                    for (int i = 0; i < 4; ++i) { const float a = acc[ai][0][m][n][i], g = acc[ai][1][m][n][i]; h[4 * n + i] = a * sigm(a) * g; }
                u32x4 w; w.x = cvt_pk_bf16(h[0], h[1]); w.y = cvt_pk_bf16(h[2], h[3]); w.z = cvt_pk_bf16(h[4], h[5]); w.w = cvt_pk_bf16(h[6], h[7]);
                *(u32x4*)(H + (size_t)(row0 + ai * HALF + m * 16) * ldh + col0) = w;
            }
    }
};
struct EpiResid {
    static constexpr bool PERM = true, AFTER_DRAIN = false;
    const bf16_t* X; bf16_t* T; float s;
    __device__ __forceinline__ void operator()(const f32x4 (&acc)[2][2][4][2], const Unit& u, int wr, int wc, int fr, int fq) const {
        const int row0 = u.pm * BM + wr * 64 + fr, col0 = u.pn * BM + wc * 32 + 8 * fq;
#pragma unroll
        for (int ai = 0; ai < 2; ++ai)
#pragma unroll
            for (int m = 0; m < 4; ++m)
#pragma unroll
                for (int bj = 0; bj < 2; ++bj) {
                    const size_t off = (size_t)(row0 + ai * HALF + m * 16) * 1024 + col0 + bj * HALF;
                    const u32x4 xv = *(const u32x4*)(X + off); const f32x4 a0 = acc[ai][bj][m][0], a1 = acc[ai][bj][m][1];
                    u32x4 w;
                    w.x = cvt_pk_bf16(ALPHA_RES * bf_lo(xv.x) + s * a0[0], ALPHA_RES * bf_hi(xv.x) + s * a0[1]);
                    w.y = cvt_pk_bf16(ALPHA_RES * bf_lo(xv.y) + s * a0[2], ALPHA_RES * bf_hi(xv.y) + s * a0[3]);
                    w.z = cvt_pk_bf16(ALPHA_RES * bf_lo(xv.z) + s * a1[0], ALPHA_RES * bf_hi(xv.z) + s * a1[1]);
                    w.w = cvt_pk_bf16(ALPHA_RES * bf_lo(xv.w) + s * a1[2], ALPHA_RES * bf_hi(xv.w) + s * a1[3]);
                    *(u32x4*)(T + off) = w;
                }
    }
};
struct EpiGlu {
    static constexpr bool PERM = true, AFTER_DRAIN = false;
    const bf16_t* X; bf16_t* T;
    __device__ __forceinline__ void operator()(const f32x4 (&acc)[2][2][4][2], const Unit& u, int wr, int wc, int fr, int fq) const {
        const int row0 = u.pm * BM + wr * 64 + fr, col0 = u.pn * HALF + wc * 32 + 8 * fq;
#pragma unroll
        for (int ai = 0; ai < 2; ++ai)
#pragma unroll
            for (int m = 0; m < 4; ++m) {
                const size_t off = (size_t)(row0 + ai * HALF + m * 16) * 1024 + col0;
                const u32x4 xv = *(const u32x4*)(X + off);
                const f32x4 o0 = acc[ai][0][m][0], o1 = acc[ai][0][m][1], g0 = acc[ai][1][m][0], g1 = acc[ai][1][m][1];
                u32x4 w;
                w.x = cvt_pk_bf16(ALPHA_RES * bf_lo(xv.x) + o0[0] * sigm(g0[0]), ALPHA_RES * bf_hi(xv.x) + o0[1] * sigm(g0[1]));
                w.y = cvt_pk_bf16(ALPHA_RES * bf_lo(xv.y) + o0[2] * sigm(g0[2]), ALPHA_RES * bf_hi(xv.y) + o0[3] * sigm(g0[3]));
                w.z = cvt_pk_bf16(ALPHA_RES * bf_lo(xv.z) + o1[0] * sigm(g1[0]), ALPHA_RES * bf_hi(xv.z) + o1[1] * sigm(g1[1]));
                w.w = cvt_pk_bf16(ALPHA_RES * bf_lo(xv.w) + o1[2] * sigm(g1[2]), ALPHA_RES * bf_hi(xv.w) + o1[3] * sigm(g1[3]));
                *(u32x4*)(T + off) = w;
            }
    }
};
struct EpiQ {
    static constexpr bool PERM = true, AFTER_DRAIN = false;
    bf16_t* Q; const float* rc; const float* rs; float qscale;
    __device__ __forceinline__ void operator()(const f32x4 (&acc)[2][2][4][2], const Unit& u, int wr, int wc, int fr, int fq) const {
        const int row0 = u.pm * BM + wr * 64 + fr, hh = 4 * u.pn + wc;
#pragma unroll
        for (int ai = 0; ai < 2; ++ai)
#pragma unroll
            for (int m = 0; m < 4; ++m) {
                const int row = row0 + ai * HALF + m * 16;
                const int pos = row < 65536 ? (row & 2047) : 4096 + ((row - 65536) & 63);
                float lo[8], hi[8];
#pragma unroll
                for (int n = 0; n < 2; ++n) {
                    const f32x4 c = *(const f32x4*)(rc + pos * 32 + 8 * fq + 4 * n), s = *(const f32x4*)(rs + pos * 32 + 8 * fq + 4 * n);
                    const f32x4 x1 = acc[ai][0][m][n], x2 = acc[ai][1][m][n];
#pragma unroll
                    for (int i = 0; i < 4; ++i) { lo[4 * n + i] = (x1[i] * c[i] - x2[i] * s[i]) * qscale; hi[4 * n + i] = (x1[i] * s[i] + x2[i] * c[i]) * qscale; }
                }
                bf16_t* dst = Q + (size_t)row * 1024 + 64 * hh + 8 * fq;
                u32x4 w; w.x = cvt_pk_bf16(lo[0], lo[1]); w.y = cvt_pk_bf16(lo[2], lo[3]); w.z = cvt_pk_bf16(lo[4], lo[5]); w.w = cvt_pk_bf16(lo[6], lo[7]);
                *(u32x4*)dst = w;
                w.x = cvt_pk_bf16(hi[0], hi[1]); w.y = cvt_pk_bf16(hi[2], hi[3]); w.z = cvt_pk_bf16(hi[4], hi[5]); w.w = cvt_pk_bf16(hi[6], hi[7]);
                *(u32x4*)(dst + 32) = w;
            }
    }
};
struct EpiKV {
    static constexpr bool PERM = true, AFTER_DRAIN = false;
    bf16_t *KBp, *VBp, *KCp, *VCp;
    float *pk, *pv, *sk, *sv;
    const float* rc; const float* rs;
    __device__ __forceinline__ void operator()(const f32x4 (&acc)[2][2][4][2], const Unit& u, int wr, int wc, int fr, int fq) const {
        const int row0 = u.pm * BM + wr * 64 + fr; const bool isk = u.pn < 4;
#pragma unroll
        for (int ai = 0; ai < 2; ++ai)
#pragma unroll
            for (int m = 0; m < 4; ++m) {
                const int row = row0 + ai * HALF + m * 16; const bool pr = row < 65536; const int rs_ = row - 65536;
                const int pos = pr ? (row & 2047) : 4096 + (rs_ & 63);
                const size_t brow = pr ? (size_t)row : (size_t)((rs_ >> 6) * 4160 + 4096 + (rs_ & 63));
                const size_t frow = pr ? (size_t)row : (size_t)rs_;
                if (isk) {
                    const int hh = 4 * u.pn + wc;
                    float lo[8], hi[8];
#pragma unroll
                    for (int n = 0; n < 2; ++n) {
                        const f32x4 c = *(const f32x4*)(rc + pos * 32 + 8 * fq + 4 * n), s = *(const f32x4*)(rs + pos * 32 + 8 * fq + 4 * n);
                        const f32x4 x1 = acc[ai][0][m][n], x2 = acc[ai][1][m][n];
#pragma unroll
                        for (int i = 0; i < 4; ++i) { lo[4 * n + i] = x1[i] * c[i] - x2[i] * s[i]; hi[4 * n + i] = x1[i] * s[i] + x2[i] * c[i]; }
                    }
                    bf16_t* dst = (pr ? KBp : KCp) + brow * 1024 + 64 * hh + 8 * fq;
                    u32x4 w; w.x = cvt_pk_bf16(lo[0], lo[1]); w.y = cvt_pk_bf16(lo[2], lo[3]); w.z = cvt_pk_bf16(lo[4], lo[5]); w.w = cvt_pk_bf16(lo[6], lo[7]);
                    *(u32x4*)dst = w;
                    w.x = cvt_pk_bf16(hi[0], hi[1]); w.y = cvt_pk_bf16(hi[2], hi[3]); w.z = cvt_pk_bf16(hi[4], hi[5]); w.w = cvt_pk_bf16(hi[6], hi[7]);
                    *(u32x4*)(dst + 32) = w;
                    float* fd = (pr ? pk : sk) + frow * 1024 + 64 * hh + 8 * fq;
                    *(f32x4*)fd = (f32x4){lo[0], lo[1], lo[2], lo[3]}; *(f32x4*)(fd + 4) = (f32x4){lo[4], lo[5], lo[6], lo[7]};
                    *(f32x4*)(fd + 32) = (f32x4){hi[0], hi[1], hi[2], hi[3]}; *(f32x4*)(fd + 36) = (f32x4){hi[4], hi[5], hi[6], hi[7]};
                } else {
                    const int col0 = (u.pn - 4) * BM + wc * 32 + 8 * fq;
#pragma unroll
                    for (int bj = 0; bj < 2; ++bj) {
                        const f32x4 a0 = acc[ai][bj][m][0], a1 = acc[ai][bj][m][1];
                        u32x4 w; w.x = cvt_pk_bf16(a0[0], a0[1]); w.y = cvt_pk_bf16(a0[2], a0[3]); w.z = cvt_pk_bf16(a1[0], a1[1]); w.w = cvt_pk_bf16(a1[2], a1[3]);
                        *(u32x4*)((pr ? VBp : VCp) + brow * 1024 + col0 + bj * HALF) = w;
                        float* fd = (pr ? pv : sv) + frow * 1024 + col0 + bj * HALF;
                        *(f32x4*)fd = a0; *(f32x4*)(fd + 4) = a1;
                    }
                }
            }
    }
};
template <class Epi, class Sched, bool ALIGN_EPI = false, bool SP2 = false>
__device__ __forceinline__ void gemm_phase(PG8_LAS unsigned char* lds, const Gemm g, const Sched& S, const Epi& E) {
    const int tid = threadIdx.x, wid = __builtin_amdgcn_readfirstlane(tid >> 6), lane = tid & 63, wr = wid >> 2, wc = wid & 3, fr = lane & 15, fq = lane >> 4;
    const int K = g.K, nt = K / BK;
    unsigned voffA[2], voffB[2];
#pragma unroll
    for (int i = 0; i < 2; ++i) { int R, C; stage_rc(tid * 16 + i * 8192, R, C); const int Rb = Epi::PERM ? ((R & ~31) + perm32(R & 31)) : R;
        voffA[i] = (unsigned)(R * K + C) * 2u; voffB[i] = (unsigned)(Rb * K + C) * 2u; }
    const size_t kstep = (size_t)(BK * 2);
    const size_t hstep = (size_t)HALF * K * 2;
    const size_t tstep = 2 * hstep;
    const unsigned ldsw = (unsigned)wid * 1024u;
    const int aoff = lds_byte(wr * 64 + fr, fq * 8), boff = lds_byte(wc * 32 + fr, fq * 8);
#define PG8_SA(b, h) (((b) * 2 + (h)) * HTB)
#define PG8_SB(b, h) ((4 + (b) * 2 + (h)) * HTB)
#define PG8_STAGE(bufoff, gbase, voff) do { _Pragma("unroll") for (int _i = 0; _i < 2; ++_i) \
        __builtin_amdgcn_global_load_lds((const unsigned*)((const char*)(gbase) + (voff)[_i]), (PG8_LAS unsigned*)(lds + (bufoff) + ldsw + _i * 8192), 16, 0, 0); } while (0)
#define PG8_LDA(dst, b, h) do { _Pragma("unroll") for (int m = 0; m < 4; ++m) _Pragma("unroll") for (int k = 0; k < 2; ++k) dst[m][k] = *(const PG8_LAS bf16x8*)(lds + PG8_SA(b, h) + aoff + m * 2048 + k * 1024); } while (0)
#define PG8_LDB(dst, b, h) do { _Pragma("unroll") for (int n = 0; n < 2; ++n) _Pragma("unroll") for (int k = 0; k < 2; ++k) dst[n][k] = *(const PG8_LAS bf16x8*)(lds + PG8_SB(b, h) + boff + n * 2048 + k * 1024); } while (0)
#define PG8_MMA(ai, bj, At, Bt) do { __builtin_amdgcn_s_setprio(1); _Pragma("unroll") for (int m = 0; m < 4; ++m) _Pragma("unroll") for (int n = 0; n < 2; ++n) _Pragma("unroll") for (int k = 0; k < 2; ++k) \
        acc[ai][bj][m][n] = __builtin_amdgcn_mfma_f32_16x16x32_bf16(Bt[n][k], At[m][k], acc[ai][bj][m][n], 0, 0, 0); __builtin_amdgcn_s_setprio(0); } while (0)
#define PG8_WAIT_V(n) asm volatile("s_waitcnt vmcnt(" #n ")" ::: "memory")
#define PG8_WAIT_L(n) asm volatile("s_waitcnt lgkmcnt(" #n ")" ::: "memory")
#define PG8_BAR __builtin_amdgcn_s_barrier()
#define PG8_SCHED __builtin_amdgcn_sched_barrier(0)
    Unit cur, nxt; int ui = 0;
    if (!S.next(0, cur)) return;
    f32x4 acc[2][2][4][2];
#pragma unroll
    for (int a = 0; a < 2; ++a)
#pragma unroll
        for (int b = 0; b < 2; ++b)
#pragma unroll
            for (int m = 0; m < 4; ++m)
#pragma unroll
                for (int n = 0; n < 2; ++n) acc[a][b][m][n] = (f32x4){0.f, 0.f, 0.f, 0.f};
    bf16x8 At[4][2], B0[2][2], B1[2][2];
    const char* cA = (const char*)g.A + (size_t)cur.pm * tstep; const char* cB = (const char*)g.Bt + (size_t)cur.pn * tstep;
    S.a_ready(cur);
    if constexpr (SP2) {
        PG8_STAGE(PG8_SB(0, 0), cB, voffB); PG8_STAGE(PG8_SB(0, 1), cB + hstep, voffB); PG8_STAGE(PG8_SA(0, 0), cA, voffA); PG8_STAGE(PG8_SA(0, 1), cA + hstep, voffA);
        if (wr == 1) PG8_BAR;
        PG8_WAIT_V(2); PG8_BAR;
        PG8_STAGE(PG8_SB(1, 0), cB + kstep, voffB); PG8_STAGE(PG8_SA(1, 0), cA + kstep, voffA); PG8_STAGE(PG8_SB(1, 1), cB + hstep + kstep, voffB);
        PG8_WAIT_V(6); PG8_BAR;
    } else {
        PG8_STAGE(PG8_SB(0, 0), cB, voffB); PG8_STAGE(PG8_SA(0, 0), cA, voffA); PG8_STAGE(PG8_SB(0, 1), cB + hstep, voffB); PG8_STAGE(PG8_SA(0, 1), cA + hstep, voffA);
        if (wr == 1) PG8_BAR;
        PG8_WAIT_V(4); PG8_BAR;
        PG8_STAGE(PG8_SB(1, 0), cB + kstep, voffB); PG8_STAGE(PG8_SA(1, 0), cA + kstep, voffA); PG8_STAGE(PG8_SB(1, 1), cB + hstep + kstep, voffB);
        PG8_WAIT_V(6); PG8_BAR;
    }
    for (;;) {
        const bool has_next = S.next(ui + 1, nxt);
        const char* nA = has_next ? (const char*)g.A + (size_t)nxt.pm * tstep : cA; const char* nB = has_next ? (const char*)g.Bt + (size_t)nxt.pn * tstep : cB;
        for (int t = 0; t < nt; t += 2) {
            const bool last = (t == nt - 2);
            const char* a1 = cA + (size_t)(t + 1) * kstep;
            const char* a2 = last ? nA : cA + (size_t)(t + 2) * kstep; const char* b2 = last ? nB : cB + (size_t)(t + 2) * kstep;
            const char* a3 = a2 + kstep; const char* b3 = b2 + kstep;
            if (last && has_next) S.a_ready(nxt);
            if constexpr (SP2) {
            PG8_LDB(B0, 0, 0); PG8_LDB(B1, 0, 1); PG8_SCHED; PG8_LDA(At, 0, 0); PG8_STAGE(PG8_SA(1, 1), a1 + hstep, voffA);
            PG8_WAIT_V(8); PG8_WAIT_L(0); PG8_BAR; PG8_MMA(0, 0, At, B0); PG8_MMA(0, 1, At, B1); PG8_BAR; PG8_SCHED;
            PG8_LDA(At, 0, 1); PG8_STAGE(PG8_SB(0, 0), b2, voffB); PG8_STAGE(PG8_SB(0, 1), b2 + hstep, voffB); PG8_STAGE(PG8_SA(0, 0), a2, voffA);
            PG8_WAIT_V(8); PG8_WAIT_L(0); PG8_BAR; PG8_MMA(1, 0, At, B0); PG8_MMA(1, 1, At, B1); PG8_BAR; PG8_SCHED;
            PG8_LDB(B0, 1, 0); PG8_LDB(B1, 1, 1); PG8_SCHED; PG8_LDA(At, 1, 0); PG8_STAGE(PG8_SA(0, 1), a2 + hstep, voffA);
            PG8_WAIT_V(8); PG8_WAIT_L(0); PG8_BAR; PG8_MMA(0, 0, At, B0); PG8_MMA(0, 1, At, B1); PG8_BAR; PG8_SCHED;
            PG8_LDA(At, 1, 1); PG8_STAGE(PG8_SB(1, 0), b3, voffB); PG8_STAGE(PG8_SB(1, 1), b3 + hstep, voffB); PG8_STAGE(PG8_SA(1, 0), a3, voffA);
            PG8_WAIT_V(8); PG8_WAIT_L(0); PG8_BAR; PG8_MMA(1, 0, At, B0); PG8_MMA(1, 1, At, B1); PG8_BAR; PG8_SCHED;
            } else {
            PG8_LDB(B0, 0, 0); PG8_SCHED; PG8_LDA(At, 0, 0); PG8_STAGE(PG8_SA(1, 1), a1 + hstep, voffA);
            PG8_WAIT_L(8); PG8_BAR; PG8_WAIT_L(0); PG8_MMA(0, 0, At, B0); PG8_BAR; PG8_SCHED;
            PG8_LDB(B1, 0, 1); PG8_STAGE(PG8_SB(0, 0), b2, voffB);
            PG8_BAR; PG8_WAIT_L(0); PG8_MMA(0, 1, At, B1); PG8_BAR;
            PG8_LDA(At, 0, 1); PG8_STAGE(PG8_SA(0, 0), a2, voffA);
            PG8_BAR; PG8_WAIT_L(0); PG8_MMA(1, 0, At, B0); PG8_BAR; PG8_SCHED;
            PG8_STAGE(PG8_SB(0, 1), b2 + hstep, voffB);
            PG8_WAIT_V(6); PG8_BAR; PG8_MMA(1, 1, At, B1); PG8_BAR;
            PG8_LDB(B0, 1, 0); PG8_SCHED; PG8_LDA(At, 1, 0); PG8_STAGE(PG8_SA(0, 1), a2 + hstep, voffA);
            PG8_WAIT_L(8); PG8_BAR; PG8_WAIT_L(0); PG8_MMA(0, 0, At, B0); PG8_BAR; PG8_SCHED;
            PG8_LDB(B1, 1, 1); PG8_STAGE(PG8_SB(1, 0), b3, voffB);
            PG8_BAR; PG8_WAIT_L(0); PG8_MMA(0, 1, At, B1); PG8_BAR;
            PG8_LDA(At, 1, 1); PG8_STAGE(PG8_SA(1, 0), a3, voffA);
            PG8_BAR; PG8_WAIT_L(0); PG8_MMA(1, 0, At, B0); PG8_BAR; PG8_SCHED;
            PG8_STAGE(PG8_SB(1, 1), b3 + hstep, voffB);
            PG8_WAIT_V(6); PG8_BAR; PG8_MMA(1, 1, At, B1); PG8_BAR;
            }
        }
        if constexpr (ALIGN_EPI) { if (wr == 0) PG8_BAR; }
        if constexpr (!Epi::AFTER_DRAIN) { E(acc, cur, wr, wc, fr, fq); S.done(cur); }
        if (!has_next) break;
#pragma unroll
        for (int a = 0; a < 2; ++a)
#pragma unroll
            for (int b = 0; b < 2; ++b)
#pragma unroll
                for (int m = 0; m < 4; ++m)
#pragma unroll
                    for (int n = 0; n < 2; ++n) acc[a][b][m][n] = (f32x4){0.f, 0.f, 0.f, 0.f};
        cur = nxt; cA = nA; cB = nB; ++ui;
        if constexpr (ALIGN_EPI) { if (wr == 1) PG8_BAR; }
    }
    PG8_WAIT_V(0);
    if constexpr (!ALIGN_EPI) { if (wr == 0) PG8_BAR; }
    PG8_BAR;
    if constexpr (Epi::AFTER_DRAIN) { E.fused(acc, cur, wr, wc, fr, fq, lds, wid, lane); S.done(cur); }
#undef PG8_SA
#undef PG8_SB
#undef PG8_STAGE
#undef PG8_LDA
#undef PG8_LDB
#undef PG8_MMA
#undef PG8_WAIT_V
#undef PG8_WAIT_L
#undef PG8_BAR
#undef PG8_SCHED
}
}
#ifndef PG8_SP2
#define PG8_SP2 true
#endif
namespace attn_body {
using bf16=__hip_bfloat16;
using bf16x8=__attribute__((ext_vector_type(8)))short;
using s16x4=__attribute__((ext_vector_type(4)))short;
using f32x16=__attribute__((ext_vector_type(16)))float;
using u32x4=__attribute__((ext_vector_type(4)))unsigned;
constexpr int D=64,DM=1024;
constexpr int NW=8,QBLK=32,KVBLK=64;
__device__ __forceinline__ int crow(int r,int hi){return (r&3)+8*(r>>2)+4*hi;}
#define SBAR() __builtin_amdgcn_sched_barrier(0)
constexpr int NSLOT=3, SLOTB=8192, RSLOT=2*SLOTB;
constexpr int LDS_K=0, LDS_V=NSLOT*RSLOT, LDS_WS=2*NSLOT*RSLOT, LDS_OST=LDS_WS+NW*64*4, LDS_BYTES=LDS_OST+NW*4096;
constexpr float C2=0.125f*1.4426950408889634f;
__device__ __forceinline__ void glds16(const void*gsrc,unsigned lds_dst){unsigned keep;
  asm volatile("s_mov_b32 %0, m0\n\ts_mov_b32 m0, %2\n\ts_nop 0\n\tglobal_load_lds_dwordx4 %1, off\n\ts_mov_b32 m0, %0":"=&s"(keep):"v"(gsrc),"s"(lds_dst):"memory");}
__device__ __forceinline__ void glds16s(const void*sbase,unsigned voff,unsigned lds_dst){unsigned keep;
  asm volatile("s_mov_b32 %0, m0\n\ts_mov_b32 m0, %3\n\ts_nop 4\n\tglobal_load_lds_dwordx4 %1, %2\n\ts_mov_b32 m0, %0":"=&s"(keep):"v"(voff),"s"(sbase),"s"(lds_dst):"memory");}
__device__ __forceinline__ const char* uni64(const void*p){ const unsigned long long v=(unsigned long long)p; const unsigned lo=__builtin_amdgcn_readfirstlane((unsigned)v),hi=__builtin_amdgcn_readfirstlane((unsigned)(v>>32)); return (const char*)(((unsigned long long)hi<<32)|lo); }
__device__ __forceinline__ float max3f(float a,float b,float c){float r;asm("v_max3_f32 %0, %1, %2, %3":"=v"(r):"v"(a),"v"(b),"v"(c));return r;}
__device__ __forceinline__ float max2f(float a,float b){float r;asm("v_max_f32_e32 %0, %1, %2":"=v"(r):"v"(a),"v"(b));return r;}
__device__ __forceinline__ float fadd_s(float a,float b){float r;asm("v_add_f32_e32 %0, %1, %2":"=v"(r):"v"(a),"v"(b));return r;}
__device__ __forceinline__ float fsub_s(float a,float b){float r;asm("v_sub_f32_e32 %0, %1, %2":"=v"(r):"v"(a),"v"(b));return r;}
typedef float f32x2_t __attribute__((ext_vector_type(2))); typedef __bf16 bf16x2_t __attribute__((ext_vector_type(2)));
__device__ __forceinline__ unsigned cvtpk_s(float lo,float hi){f32x2_t v={lo,hi};bf16x2_t b=__builtin_convertvector(v,bf16x2_t);return __builtin_bit_cast(unsigned,b);}
#define WAIT_BAR(N) asm volatile("s_waitcnt vmcnt(" #N ") lgkmcnt(0)\n\ts_barrier":::"memory")

__device__ __forceinline__ void qkt(f32x16&p0,f32x16&p1,const char*Kslot,const bf16x8*qr,const f32x16&negm,int r32,int hi){
  const char*kb=Kslot+hi*1024+r32*16;
  #pragma unroll
  for(int d0=0;d0<4;++d0){
    const bf16x8 b0=*reinterpret_cast<const bf16x8*>(kb+d0*2048);
    const bf16x8 b1=*reinterpret_cast<const bf16x8*>(kb+d0*2048+512);
    if(d0==0){p0=__builtin_amdgcn_mfma_f32_32x32x16_bf16(b0,qr[0],negm,0,0,0);p1=__builtin_amdgcn_mfma_f32_32x32x16_bf16(b1,qr[0],negm,0,0,0);}
    else{p0=__builtin_amdgcn_mfma_f32_32x32x16_bf16(b0,qr[d0],p0,0,0,0);p1=__builtin_amdgcn_mfma_f32_32x32x16_bf16(b1,qr[d0],p1,0,0,0);}}
}
typedef __attribute__((address_space(3))) const char* lds_cptr;
typedef short v4i16_t __attribute__((ext_vector_type(4)));
__device__ __forceinline__ void kload8(bf16x8*kf,lds_cptr kp){
  kf[0]=*(const __attribute__((address_space(3))) bf16x8*)(kp);      kf[1]=*(const __attribute__((address_space(3))) bf16x8*)(kp+512);
  kf[2]=*(const __attribute__((address_space(3))) bf16x8*)(kp+2048); kf[3]=*(const __attribute__((address_space(3))) bf16x8*)(kp+2560);
  kf[4]=*(const __attribute__((address_space(3))) bf16x8*)(kp+4096); kf[5]=*(const __attribute__((address_space(3))) bf16x8*)(kp+4608);
  kf[6]=*(const __attribute__((address_space(3))) bf16x8*)(kp+6144); kf[7]=*(const __attribute__((address_space(3))) bf16x8*)(kp+6656);
}
__device__ __forceinline__ void kload2(bf16x8*kf,lds_cptr kp,int j){ kf[2*j]=*(const __attribute__((address_space(3))) bf16x8*)(kp+j*2048); kf[2*j+1]=*(const __attribute__((address_space(3))) bf16x8*)(kp+j*2048+512); }
__device__ __forceinline__ s16x4 vtr(lds_cptr p){ return __builtin_bit_cast(s16x4,__builtin_amdgcn_ds_read_tr16_b64_v4i16((__attribute__((address_space(3))) v4i16_t*)p)); }
__device__ __forceinline__ float rowmax(const f32x16&p0,const f32x16&p1){
  float a=max3f(p0[0],p0[1],p1[0]),b=max3f(p0[2],p0[3],p1[1]);a=max3f(a,p1[2],p1[3]);
  #pragma unroll
  for(int r=4;r<16;r+=4){a=max3f(a,p0[r],p0[r+1]);b=max3f(b,p0[r+2],p0[r+3]);a=max3f(a,p1[r],p1[r+1]);b=max3f(b,p1[r+2],p1[r+3]);}
  const float m=max2f(a,b);
  auto rr=__builtin_amdgcn_permlane32_swap(__float_as_uint(m),__float_as_uint(m),false,false);
  return max2f(__uint_as_float(rr[0]),__uint_as_float(rr[1]));
}
__device__ __forceinline__ void pv(f32x16*o,int vb,bf16x8 pa0,bf16x8 pa1,bf16x8 pa2,bf16x8 pa3){
  #pragma unroll
  for(int d0=0;d0<2;++d0){s16x4 lo[4],hi[4];
    #pragma unroll
    for(int ks=0;ks<4;++ks){
      asm volatile("ds_read_b64_tr_b16 %0,%1 offset:%c2":"=&v"(lo[ks]):"v"(vb),"i"(d0*4096+ks*1024):"memory");
      asm volatile("ds_read_b64_tr_b16 %0,%1 offset:%c2":"=&v"(hi[ks]):"v"(vb),"i"(d0*4096+ks*1024+512):"memory");}
    asm volatile("s_waitcnt lgkmcnt(0)":::"memory");SBAR();
    #define PK(k) (bf16x8){lo[k][0],lo[k][1],lo[k][2],lo[k][3],hi[k][0],hi[k][1],hi[k][2],hi[k][3]}
    o[d0]=__builtin_amdgcn_mfma_f32_32x32x16_bf16(pa0,PK(0),o[d0],0,0,0);
    o[d0]=__builtin_amdgcn_mfma_f32_32x32x16_bf16(pa1,PK(1),o[d0],0,0,0);
    o[d0]=__builtin_amdgcn_mfma_f32_32x32x16_bf16(pa2,PK(2),o[d0],0,0,0);
    o[d0]=__builtin_amdgcn_mfma_f32_32x32x16_bf16(pa3,PK(3),o[d0],0,0,0);
    #undef PK
  }
}

#ifndef ATTN_STORE16
#define ATTN_STORE16(p,v) (*(u32x4*)(p)=(v))
#endif
template<int THRL> __device__ __forceinline__ void attn_unit(const bf16*Qw,const bf16*__restrict__ Kh,const bf16*__restrict__ Vh,bf16*Ow,int NTr,char*shm){
  const int tid=threadIdx.x,lane=tid&63,r32=lane&31,hi=lane>>5; const int wid=__builtin_amdgcn_readfirstlane(tid>>6);
  const int wm=wid>>2, wv=(wid>>1)&1;
  const unsigned lds0=(unsigned)(uintptr_t)shm;
  float*wsf=(float*)(shm+LDS_WS)+wid*64;
  const char*Kb=uni64(Kh); const char*Vb=uni64(Vh);
  const unsigned kvoff=(unsigned)((lane*DM+wid*8)*2);
  const unsigned vvoff=(unsigned)(((16*(wid&3)+(lane>>2))*DM+(wid>>2)*32+(lane&3)*8)*2);
  const unsigned kdst=lds0+LDS_K+wid*1024, vdst=lds0+LDS_V+wid*1024;
  const int NT=(NTr<=4)?4:((NTr+1)&~1); const int tmax=NTr-1;
  #define TCL(t) (((t)<tmax)?(t):tmax)
  #define DMA_K(t,slot) do{ const char*b_=Kb+(long)TCL(t)*(KVBLK*DM*2); glds16s(b_,kvoff,(unsigned)__builtin_amdgcn_readfirstlane(kdst+(slot))); glds16s(b_+128,kvoff,(unsigned)__builtin_amdgcn_readfirstlane(kdst+SLOTB+(slot))); }while(0)
  #define DMA_V(t,slot) do{ const char*b_=Vb+(long)TCL(t)*(KVBLK*DM*2); glds16s(b_,vvoff,(unsigned)__builtin_amdgcn_readfirstlane(vdst+(slot))); glds16s(b_+128,vvoff,(unsigned)__builtin_amdgcn_readfirstlane(vdst+SLOTB+(slot))); }while(0)
  const int vb0=(int)(lds0+LDS_V)+wv*SLOTB+((lane>>4)&1)*32+(lane&3)*8+(4*hi+((lane&15)>>2))*64;
  const char*Kbase=shm+LDS_K+wm*SLOTB; bf16x8 kf[8];
  const lds_cptr shm3=(lds_cptr)shm; const lds_cptr kp0=shm3+LDS_K+wm*SLOTB+hi*1024+r32*16; const lds_cptr vp0=shm3+LDS_V+wv*SLOTB+((lane>>4)&1)*32+(lane&3)*8+(4*hi+((lane&15)>>2))*64;
  DMA_K(0,0);DMA_V(0,0);DMA_K(1,RSLOT);
  bf16x8 qr[4];
  { const char*Qb=uni64(Qw); const unsigned qoff=(unsigned)((r32*DM+hi*8)*2);
    _Pragma("unroll") for(int d0=0;d0<4;++d0)qr[d0]=*reinterpret_cast<const bf16x8*>(Qb+qoff+d0*32); }
  float mhat=0.f,l_reg=0.f;f32x16 o[2];o[0]=f32x16{};o[1]=f32x16{};f32x16 negm; _Pragma("unroll") for(int r_=0;r_<16;++r_){ float z_; asm volatile("v_mov_b32 %0, 0":"=v"(z_)); negm[r_]=z_; }
  #define CMASK(P0,P1,t) do{ if((t)>=NTr){ _Pragma("unroll") for(int r_=0;r_<16;++r_){P0[r_]=-INFINITY;P1[r_]=-INFINITY;} } }while(0)
  bool resc=false;
  #define START(P0,P1) do{ const float rm=rowmax(P0,P1); resc=false; \
    { const float dl=rm; mhat=fadd_s(mhat,dl); \
      _Pragma("unroll") for(int r=0;r<16;++r){P0[r]=fsub_s(P0[r],dl);P1[r]=fsub_s(P1[r],dl);} \
      _Pragma("unroll") for(int r=0;r<16;++r)negm[r]=-mhat; asm volatile("":"+v"(negm)); } \
    _Pragma("unroll") for(int r=0;r<16;++r)P0[r]=__builtin_amdgcn_exp2f(P0[r]); }while(0)
  #define RESC() do{ if(resc){ asm volatile("s_waitcnt lgkmcnt(0)":::"memory"); \
      _Pragma("unroll") for(int d_=0;d_<2;++d_) _Pragma("unroll") for(int r=0;r<16;++r)o[d_][r]*=wsf[crow(r,hi)]; } }while(0)
  f32x16 pA0,pA1,pB0,pB1;
  int sl_prev=0,sl_cur=0,sl_next=RSLOT;
  #define ROT() do{sl_prev=sl_cur;sl_cur=sl_next;sl_next=(sl_next==(NSLOT-1)*RSLOT)?0:sl_next+RSLOT;}while(0)
  DMA_K(2,2*RSLOT);
  WAIT_BAR(6);
  qkt(pA0,pA1,Kbase,qr,negm,r32,hi);asm volatile("s_nop 15\n\ts_nop 7":"+v"(pA0),"+v"(pA1));
  START(pA0,pA1);
  _Pragma("unroll") for(int r=0;r<16;++r)pA1[r]=__builtin_amdgcn_exp2f(pA1[r]);
  WAIT_BAR(0);
  DMA_K(3,0);DMA_V(1,RSLOT);
  ROT();
  kload8(kf,kp0+sl_cur);
  WAIT_BAR(4);
  s16x4 vlo[8],vhi[8]; u32x4 pw0,pw1,pw2,pw3;
  #define PKW(P,B) cvtpk_s(P[B],P[B+1])
  #define PAF(k) __builtin_bit_cast(bf16x8,pw##k)
  #define VFR(i) (bf16x8){vlo[i][0],vlo[i][1],vlo[i][2],vlo[i][3],vhi[i][0],vhi[i][1],vhi[i][2],vhi[i][3]}
  #define PIN(x) asm volatile("":"+v"(x))
  #define MX3(a,b,c) __builtin_fmaxf(__builtin_fmaxf((a),(b)),(c))
  #define GAPA(MF,A0,A1,A2,A3,W0,W1,PW) do{ MF; sacc+=A0; sacc+=A1; sacc+=A2; sacc+=A3; PIN(sacc); W0; W1; PIN(PW); SBAR(); }while(0)
  #define EX(v) __builtin_amdgcn_exp2f(v)
  #define GAPB(MF,X,B) do{ MF; X[B]=EX(X[B]); X[B+1]=EX(X[B+1]); X[B+2]=EX(X[B+2]); X[B+3]=EX(X[B+3]); PIN(X); SBAR(); }while(0)
  #define VRD(i) do{ vlo[i]=vtr(vp_+(((i)>>2)*4096+((i)&3)*1024)); vhi[i]=vtr(vp_+(((i)>>2)*4096+((i)&3)*1024+512)); }while(0)
  #define KRD(G,j) do{ if(G){ kload2(kf,kp0+sl_next,j); SBAR(); } }while(0)
  #define STEP(C0,C1,P0,P1,t,GK,GV,GL) do{ SBAR(); \
    const lds_cptr vp_=vp0+sl_prev; \
    VRD(0); SBAR(); float sacc=(P0[0]+P0[1]); \
    GAPA(C0=__builtin_amdgcn_mfma_f32_32x32x16_bf16(kf[0],qr[0],negm,0,0,0), P0[2],P0[3],P0[4],P0[5],     pw0[0]=PKW(P0,0), pw0[1]=PKW(P0,2), pw0); \
    VRD(4); SBAR(); GAPA(C1=__builtin_amdgcn_mfma_f32_32x32x16_bf16(kf[1],qr[0],negm,0,0,0), P0[6],P0[7],P0[8],P0[9],     pw0[2]=PKW(P0,4), pw0[3]=PKW(P0,6), pw0); \
    VRD(1); SBAR(); GAPA(C0=__builtin_amdgcn_mfma_f32_32x32x16_bf16(kf[2],qr[1],C0,0,0,0),   P0[10],P0[11],P0[12],P0[13], pw1[0]=PKW(P0,8), pw1[1]=PKW(P0,10), pw1); \
    VRD(5); SBAR(); GAPA(C1=__builtin_amdgcn_mfma_f32_32x32x16_bf16(kf[3],qr[1],C1,0,0,0),   P0[14],P0[15],P1[0],P1[1],   pw1[2]=PKW(P0,12),pw1[3]=PKW(P0,14), pw1); \
    VRD(2); SBAR(); GAPA(C0=__builtin_amdgcn_mfma_f32_32x32x16_bf16(kf[4],qr[2],C0,0,0,0),   P1[2],P1[3],P1[4],P1[5],     pw2[0]=PKW(P1,0), pw2[1]=PKW(P1,2), pw2); \
    VRD(6); SBAR(); GAPA(C1=__builtin_amdgcn_mfma_f32_32x32x16_bf16(kf[5],qr[2],C1,0,0,0),   P1[6],P1[7],P1[8],P1[9],     pw2[2]=PKW(P1,4), pw2[3]=PKW(P1,6), pw2); \
    VRD(3); SBAR(); GAPA(C0=__builtin_amdgcn_mfma_f32_32x32x16_bf16(kf[6],qr[3],C0,0,0,0),   P1[10],P1[11],P1[12],P1[13], pw3[0]=PKW(P1,8), pw3[1]=PKW(P1,10), pw3); \
    VRD(7); SBAR(); GAPA(C1=__builtin_amdgcn_mfma_f32_32x32x16_bf16(kf[7],qr[3],C1,0,0,0),   P1[14],P1[15],0.f,0.f,       pw3[2]=PKW(P1,12),pw3[3]=PKW(P1,14), pw3); \
    l_reg+=sacc; \
    if(GK){DMA_K((t)+3,sl_cur);} if(GV){DMA_V((t)+1,sl_next);} \
    CMASK(C0,C1,t); \
    { float a=MX3(C0[0],C0[1],C1[0]),b=MX3(C0[2],C0[3],C1[1]); a=MX3(a,C1[2],C1[3]); \
      _Pragma("unroll") for(int r=4;r<16;r+=4){a=MX3(a,C0[r],C0[r+1]);b=MX3(b,C0[r+2],C0[r+3]);a=MX3(a,C1[r],C1[r+1]);b=MX3(b,C1[r+2],C1[r+3]);} \
      float rm=__builtin_fmaxf(a,b); { auto rr=__builtin_amdgcn_permlane32_swap(__float_as_uint(rm),__float_as_uint(rm),false,false); rm=__builtin_fmaxf(__uint_as_float(rr[0]),__uint_as_float(rr[1])); } \
      resc=false; \
      if(__builtin_expect(__any(rm>(float)THRL),0)){ const float dl=__builtin_fmaxf(rm,0.f); mhat+=dl; \
        _Pragma("unroll") for(int r=0;r<16;++r){C0[r]-=dl;C1[r]-=dl;} \
        _Pragma("unroll") for(int r=0;r<16;++r)negm[r]=-mhat; asm volatile("":"+v"(negm)); \
        const float f=__builtin_amdgcn_exp2f(-dl); l_reg*=f; if(hi==0)wsf[r32]=f; resc=true; } } \
    SBAR(); \
    GAPB(o[0]=__builtin_amdgcn_mfma_f32_32x32x16_bf16(PAF(0),VFR(0),o[0],0,0,0), C0,0); \
    GAPB(o[1]=__builtin_amdgcn_mfma_f32_32x32x16_bf16(PAF(0),VFR(4),o[1],0,0,0), C0,4); \
    KRD(GL,0); GAPB(o[0]=__builtin_amdgcn_mfma_f32_32x32x16_bf16(PAF(1),VFR(1),o[0],0,0,0), C0,8); \
    KRD(GL,1); GAPB(o[1]=__builtin_amdgcn_mfma_f32_32x32x16_bf16(PAF(1),VFR(5),o[1],0,0,0), C0,12); \
    KRD(GL,2); GAPB(o[0]=__builtin_amdgcn_mfma_f32_32x32x16_bf16(PAF(2),VFR(2),o[0],0,0,0), C1,0); \
    KRD(GL,3); GAPB(o[1]=__builtin_amdgcn_mfma_f32_32x32x16_bf16(PAF(2),VFR(6),o[1],0,0,0), C1,4); \
    GAPB(o[0]=__builtin_amdgcn_mfma_f32_32x32x16_bf16(PAF(3),VFR(3),o[0],0,0,0), C1,8); \
    GAPB(o[1]=__builtin_amdgcn_mfma_f32_32x32x16_bf16(PAF(3),VFR(7),o[1],0,0,0), C1,12); \
    }while(0)
  int t=1;
  #undef CMASK
  #define CMASK(P0,P1,t) do{}while(0)
  for(;t+5<NT;t+=2){
    STEP(pB0,pB1,pA0,pA1,t,true,true,true);     WAIT_BAR(4); RESC(); ROT();
    STEP(pA0,pA1,pB0,pB1,t+1,true,true,true);   WAIT_BAR(4); RESC(); ROT();
  }
  #undef CMASK
  #define CMASK(P0,P1,t) do{ if((t)>=NTr){ _Pragma("unroll") for(int r_=0;r_<16;++r_){P0[r_]=-INFINITY;P1[r_]=-INFINITY;} } }while(0)
  #define ENDW(tt) do{ if((tt)+3<NT){WAIT_BAR(4);} else if((tt)+2<NT){WAIT_BAR(2);} else {WAIT_BAR(0);} }while(0)
  for(;t+1<NT;t+=2){
    STEP(pB0,pB1,pA0,pA1,t,(t+3<NT),(t+1<NT),(t+1<NT));       ENDW(t);   RESC(); ROT();
    STEP(pA0,pA1,pB0,pB1,t+1,(t+4<NT),(t+2<NT),(t+2<NT));     ENDW(t+1); RESC(); ROT();
  }
  STEP(pB0,pB1,pA0,pA1,NT-1,false,false,false); RESC();
  { float sacc=pB0[0]+pB0[1]; _Pragma("unroll") for(int r=2;r<16;++r)sacc+=pB0[r]; _Pragma("unroll") for(int r=0;r<16;++r)sacc+=pB1[r]; l_reg+=sacc;
    pw0=(u32x4){PKW(pB0,0),PKW(pB0,2),PKW(pB0,4),PKW(pB0,6)};pw1=(u32x4){PKW(pB0,8),PKW(pB0,10),PKW(pB0,12),PKW(pB0,14)};pw2=(u32x4){PKW(pB1,0),PKW(pB1,2),PKW(pB1,4),PKW(pB1,6)};pw3=(u32x4){PKW(pB1,8),PKW(pB1,10),PKW(pB1,12),PKW(pB1,14)};
    SBAR(); pv(o,vb0+sl_cur,PAF(0),PAF(1),PAF(2),PAF(3)); }
  #undef PKW
  #undef PAF
  #undef VFR
  #undef PIN
  #undef MX3
  #undef GAPA
  #undef GAPB
  #undef EX
  #undef VRD
  #undef KRD
  #undef STEP
  #undef ENDW
  {auto rr=__builtin_amdgcn_permlane32_swap(__float_as_uint(l_reg),__float_as_uint(l_reg),false,false);l_reg=__uint_as_float(rr[0])+__uint_as_float(rr[1]);}
  if(hi==0)wsf[32+r32]=l_reg;asm volatile("s_waitcnt lgkmcnt(0)":::"memory");
  float rli[16];
  #pragma unroll
  for(int r=0;r<16;++r)rli[r]=__builtin_amdgcn_rcpf(wsf[32+crow(r,hi)]);
  { bf16*stg=(bf16*)(shm+LDS_OST)+wid*2048;
    #pragma unroll
    for(int r=0;r<16;++r){const int orow=crow(r,hi);
      #pragma unroll
      for(int d0=0;d0<2;++d0)stg[orow*64+d0*32+r32]=__float2bfloat16(o[d0][r]*rli[r]);}
    asm volatile("s_waitcnt lgkmcnt(0)":::"memory");
    #pragma unroll
    for(int i=0;i<4;++i){const int row=i*8+(lane>>3),ch=lane&7; const u32x4 v=*(const u32x4*)(stg+row*64+ch*8); ATTN_STORE16(const_cast<char*>(uni64(Ow))+(unsigned)(((i*8+(lane>>3))*DM+ch*8)*2),v);} }
  asm volatile("s_waitcnt lgkmcnt(0)\n\ts_barrier":::"memory");
  #undef DMA_K
  #undef DMA_V
  #undef TCL
  #undef CMASK
  #undef START
  #undef RESC
  #undef ROT
}
template<int THRL> __device__ __forceinline__ void attn_unit2(const bf16*Qw,const bf16*__restrict__ Kh,const bf16*__restrict__ Vh,bf16*Ow,int NTr,int NTw,char*shm){
  const int tid=threadIdx.x,lane=tid&63,r32=lane&31,hi=lane>>5; const int wid=__builtin_amdgcn_readfirstlane(tid>>6);
  const int wm=wid>>2;
  const unsigned lds0=(unsigned)(uintptr_t)shm;
  float*wsf=(float*)(shm+LDS_WS)+wid*64;
  const char*Kb=uni64(Kh); const char*Vb=uni64(Vh);
  const unsigned kvoff=(unsigned)((lane*DM+wid*8)*2);
  const unsigned vvoff=(unsigned)(((16*(wid&3)+(lane>>2))*DM+(wid>>2)*32+(lane&3)*8)*2);
  const unsigned kdst=lds0+LDS_K+wid*1024, vdst=lds0+LDS_V+wid*1024;
  const int NT=(NTr<=4)?4:((NTr+1)&~1); const int tmax=NTr-1;
  #define TCL(t) (((t)<tmax)?(t):tmax)
  #define DMA_K(t,slot) do{ const char*b_=Kb+(long)TCL(t)*(KVBLK*DM*2); glds16s(b_,kvoff,(unsigned)__builtin_amdgcn_readfirstlane(kdst+(slot))); glds16s(b_+128,kvoff,(unsigned)__builtin_amdgcn_readfirstlane(kdst+SLOTB+(slot))); }while(0)
  #define DMA_V(t,slot) do{ const char*b_=Vb+(long)TCL(t)*(KVBLK*DM*2); glds16s(b_,vvoff,(unsigned)__builtin_amdgcn_readfirstlane(vdst+(slot))); glds16s(b_+128,vvoff,(unsigned)__builtin_amdgcn_readfirstlane(vdst+SLOTB+(slot))); }while(0)
  const int vb0=(int)(lds0+LDS_V)+((lane>>4)&1)*32+(lane&3)*8+(4*hi+((lane&15)>>2))*64;
  const char*Kbase=shm+LDS_K+wm*SLOTB; bf16x8 kf[8];
  const lds_cptr shm3=(lds_cptr)shm; const lds_cptr kp0=shm3+LDS_K+wm*SLOTB+hi*1024+r32*16; const lds_cptr vp0=shm3+LDS_V+((lane>>4)&1)*32+(lane&3)*8+(4*hi+((lane&15)>>2))*64;
  DMA_K(0,0);DMA_V(0,0);DMA_K(1,RSLOT);
  bf16x8 qr[4];
  { const char*Qb=uni64(Qw); const unsigned qoff=(unsigned)((r32*DM+hi*8)*2);
    _Pragma("unroll") for(int d0=0;d0<4;++d0)qr[d0]=*reinterpret_cast<const bf16x8*>(Qb+qoff+d0*32); }
  const lds_cptr qp0=shm3+LDS_OST+wid*4096+lane*16;
  #pragma unroll
  for(int d0=0;d0<4;++d0)*(__attribute__((address_space(3))) bf16x8*)(shm3+LDS_OST+wid*4096+lane*16+d0*1024)=qr[d0];
  float mhat=0.f,l_reg=0.f;f32x16 o[4];o[0]=f32x16{};o[1]=f32x16{};o[2]=f32x16{};o[3]=f32x16{};const f32x16 negm=f32x16{};
  #define CMASK(P0,P1,t) do{ if((t)>=NTw){ _Pragma("unroll") for(int r_=0;r_<16;++r_){P0[r_]=-INFINITY;P1[r_]=-INFINITY;} } }while(0)
  bool resc=false;
  #define START(P0,P1) do{ const float rm=rowmax(P0,P1); resc=false; mhat=rm; \
    _Pragma("unroll") for(int r=0;r<16;++r)P0[r]=__builtin_amdgcn_exp2f(P0[r]-mhat); }while(0)
  #define RESC() do{ if(resc){ asm volatile("s_waitcnt lgkmcnt(0)":::"memory"); \
      _Pragma("unroll") for(int d_=0;d_<4;++d_) _Pragma("unroll") for(int r=0;r<16;++r)o[d_][r]*=wsf[crow(r,hi)]; } }while(0)
  f32x16 pA0,pA1,pB0,pB1;
  int sl_prev=0,sl_cur=0,sl_next=RSLOT;
  #define ROT() do{sl_prev=sl_cur;sl_cur=sl_next;sl_next=(sl_next==(NSLOT-1)*RSLOT)?0:sl_next+RSLOT;}while(0)
  DMA_K(2,2*RSLOT);
  WAIT_BAR(6);
  qkt(pA0,pA1,Kbase,qr,negm,r32,hi);asm volatile("s_nop 15\n\ts_nop 7":"+v"(pA0),"+v"(pA1));
  START(pA0,pA1);
  _Pragma("unroll") for(int r=0;r<16;++r)pA1[r]=__builtin_amdgcn_exp2f(pA1[r]-mhat);
  WAIT_BAR(0);
  DMA_K(3,0);DMA_V(1,RSLOT);
  ROT();
  kload8(kf,kp0+sl_cur);
  WAIT_BAR(4);
  s16x4 vlo[8],vhi[8]; u32x4 pw0,pw1,pw2,pw3;
  #define PKW(P,B) cvtpk_s(P[B],P[B+1])
  #define PAF(k) __builtin_bit_cast(bf16x8,pw##k)
  #define VFR(i) (bf16x8){vlo[i][0],vlo[i][1],vlo[i][2],vlo[i][3],vhi[i][0],vhi[i][1],vhi[i][2],vhi[i][3]}
  #define PIN(x) asm volatile("":"+v"(x))
  #define MX3(a,b,c) __builtin_fmaxf(__builtin_fmaxf((a),(b)),(c))
  #define GAPA(MF,A0,A1,A2,A3,W0,W1,PW) do{ MF; sacc+=A0; sacc+=A1; sacc+=A2; sacc+=A3; PIN(sacc); W0; W1; PIN(PW); SBAR(); }while(0)
  #define EX(v) __builtin_amdgcn_exp2f((v)-mhat)
  #define GAPB(MF,X,B) do{ MF; X[B]=EX(X[B]); X[B+1]=EX(X[B+1]); X[B+2]=EX(X[B+2]); X[B+3]=EX(X[B+3]); PIN(X); SBAR(); }while(0)
  #define VRD(i) do{ vlo[i]=vtr(vp_+(((i)>>2)*4096+((i)&3)*1024)); vhi[i]=vtr(vp_+(((i)>>2)*4096+((i)&3)*1024+512)); }while(0)
  #define KRD(G,j) do{ if(G){ kload2(kf,kp0+sl_next,j); SBAR(); } }while(0)
  #define VRD2(i) do{ vlo[i]=vtr(vp_+(SLOTB+((i)>>2)*4096+((i)&3)*1024)); vhi[i]=vtr(vp_+(SLOTB+((i)>>2)*4096+((i)&3)*1024+512)); SBAR(); }while(0)
  #define GAPC(MF) do{ MF; SBAR(); }while(0)
  #define STEP(C0,C1,P0,P1,t,GK,GV,GL) do{ SBAR(); \
    const lds_cptr vp_=vp0+sl_prev; \
    bf16x8 q0_,q1_,q2_,q3_; \
    VRD(0); q0_=*(const __attribute__((address_space(3))) bf16x8*)(qp0); SBAR(); float sacc=(P0[0]+P0[1]); \
    GAPA(C0=__builtin_amdgcn_mfma_f32_32x32x16_bf16(kf[0],q0_,negm,0,0,0), P0[2],P0[3],P0[4],P0[5],     pw0[0]=PKW(P0,0), pw0[1]=PKW(P0,2), pw0); \
    VRD(4); q1_=*(const __attribute__((address_space(3))) bf16x8*)(qp0+1024); SBAR(); GAPA(C1=__builtin_amdgcn_mfma_f32_32x32x16_bf16(kf[1],q0_,negm,0,0,0), P0[6],P0[7],P0[8],P0[9],     pw0[2]=PKW(P0,4), pw0[3]=PKW(P0,6), pw0); \
    VRD(1); SBAR(); GAPA(C0=__builtin_amdgcn_mfma_f32_32x32x16_bf16(kf[2],q1_,C0,0,0,0),   P0[10],P0[11],P0[12],P0[13], pw1[0]=PKW(P0,8), pw1[1]=PKW(P0,10), pw1); \
    VRD(5); q2_=*(const __attribute__((address_space(3))) bf16x8*)(qp0+2048); SBAR(); GAPA(C1=__builtin_amdgcn_mfma_f32_32x32x16_bf16(kf[3],q1_,C1,0,0,0),   P0[14],P0[15],P1[0],P1[1],   pw1[2]=PKW(P0,12),pw1[3]=PKW(P0,14), pw1); \
    VRD(2); SBAR(); GAPA(C0=__builtin_amdgcn_mfma_f32_32x32x16_bf16(kf[4],q2_,C0,0,0,0),   P1[2],P1[3],P1[4],P1[5],     pw2[0]=PKW(P1,0), pw2[1]=PKW(P1,2), pw2); \
    VRD(6); q3_=*(const __attribute__((address_space(3))) bf16x8*)(qp0+3072); SBAR(); GAPA(C1=__builtin_amdgcn_mfma_f32_32x32x16_bf16(kf[5],q2_,C1,0,0,0),   P1[6],P1[7],P1[8],P1[9],     pw2[2]=PKW(P1,4), pw2[3]=PKW(P1,6), pw2); \
    VRD(3); SBAR(); GAPA(C0=__builtin_amdgcn_mfma_f32_32x32x16_bf16(kf[6],q3_,C0,0,0,0),   P1[10],P1[11],P1[12],P1[13], pw3[0]=PKW(P1,8), pw3[1]=PKW(P1,10), pw3); \
    VRD(7); SBAR(); GAPA(C1=__builtin_amdgcn_mfma_f32_32x32x16_bf16(kf[7],q3_,C1,0,0,0),   P1[14],P1[15],0.f,0.f,       pw3[2]=PKW(P1,12),pw3[3]=PKW(P1,14), pw3); \
    l_reg+=sacc; \
    if(GK){DMA_K((t)+3,sl_cur);} if(GV){DMA_V((t)+1,sl_next);} \
    CMASK(C0,C1,t); \
    { float a=MX3(C0[0],C0[1],C1[0]),b=MX3(C0[2],C0[3],C1[1]); a=MX3(a,C1[2],C1[3]); \
      _Pragma("unroll") for(int r=4;r<16;r+=4){a=MX3(a,C0[r],C0[r+1]);b=MX3(b,C0[r+2],C0[r+3]);a=MX3(a,C1[r],C1[r+1]);b=MX3(b,C1[r+2],C1[r+3]);} \
      float rm=__builtin_fmaxf(a,b); { auto rr=__builtin_amdgcn_permlane32_swap(__float_as_uint(rm),__float_as_uint(rm),false,false); rm=__builtin_fmaxf(__uint_as_float(rr[0]),__uint_as_float(rr[1])); } \
      rm-=mhat; resc=false; \
      if(__builtin_expect(__any(rm>(float)THRL),0)){ const float dl=__builtin_fmaxf(rm,0.f); mhat+=dl; \
        const float f=__builtin_amdgcn_exp2f(-dl); l_reg*=f; if(hi==0)wsf[r32]=f; resc=true; } } \
    SBAR(); \
    GAPB(o[0]=__builtin_amdgcn_mfma_f32_32x32x16_bf16(PAF(0),VFR(0),o[0],0,0,0), C0,0);  VRD2(0); \
    GAPB(o[1]=__builtin_amdgcn_mfma_f32_32x32x16_bf16(PAF(0),VFR(4),o[1],0,0,0), C0,4);  VRD2(4); \
    GAPB(o[0]=__builtin_amdgcn_mfma_f32_32x32x16_bf16(PAF(1),VFR(1),o[0],0,0,0), C0,8);  VRD2(1); \
    GAPB(o[1]=__builtin_amdgcn_mfma_f32_32x32x16_bf16(PAF(1),VFR(5),o[1],0,0,0), C0,12); VRD2(5); \
    GAPB(o[0]=__builtin_amdgcn_mfma_f32_32x32x16_bf16(PAF(2),VFR(2),o[0],0,0,0), C1,0);  VRD2(2); \
    GAPB(o[1]=__builtin_amdgcn_mfma_f32_32x32x16_bf16(PAF(2),VFR(6),o[1],0,0,0), C1,4);  VRD2(6); \
    GAPB(o[0]=__builtin_amdgcn_mfma_f32_32x32x16_bf16(PAF(3),VFR(3),o[0],0,0,0), C1,8);  VRD2(3); \
    GAPB(o[1]=__builtin_amdgcn_mfma_f32_32x32x16_bf16(PAF(3),VFR(7),o[1],0,0,0), C1,12); VRD2(7); \
    GAPC(o[2]=__builtin_amdgcn_mfma_f32_32x32x16_bf16(PAF(0),VFR(0),o[2],0,0,0)); \
    GAPC(o[3]=__builtin_amdgcn_mfma_f32_32x32x16_bf16(PAF(0),VFR(4),o[3],0,0,0)); \
    KRD(GL,0); GAPC(o[2]=__builtin_amdgcn_mfma_f32_32x32x16_bf16(PAF(1),VFR(1),o[2],0,0,0)); \
    KRD(GL,1); GAPC(o[3]=__builtin_amdgcn_mfma_f32_32x32x16_bf16(PAF(1),VFR(5),o[3],0,0,0)); \
    KRD(GL,2); GAPC(o[2]=__builtin_amdgcn_mfma_f32_32x32x16_bf16(PAF(2),VFR(2),o[2],0,0,0)); \
    KRD(GL,3); GAPC(o[3]=__builtin_amdgcn_mfma_f32_32x32x16_bf16(PAF(2),VFR(6),o[3],0,0,0)); \
    GAPC(o[2]=__builtin_amdgcn_mfma_f32_32x32x16_bf16(PAF(3),VFR(3),o[2],0,0,0)); \
    GAPC(o[3]=__builtin_amdgcn_mfma_f32_32x32x16_bf16(PAF(3),VFR(7),o[3],0,0,0)); \
    }while(0)
  int t=1;
  #undef CMASK
  #define CMASK(P0,P1,t) do{}while(0)
  for(;t+5<NT;t+=2){
    STEP(pB0,pB1,pA0,pA1,t,true,true,true);     WAIT_BAR(4); RESC(); ROT();
    STEP(pA0,pA1,pB0,pB1,t+1,true,true,true);   WAIT_BAR(4); RESC(); ROT();
  }
  #undef CMASK
  #define CMASK(P0,P1,t) do{ if((t)>=NTw){ _Pragma("unroll") for(int r_=0;r_<16;++r_){P0[r_]=-INFINITY;P1[r_]=-INFINITY;} } }while(0)
  #define ENDW(tt) do{ if((tt)+3<NT){WAIT_BAR(4);} else if((tt)+2<NT){WAIT_BAR(2);} else {WAIT_BAR(0);} }while(0)
  for(;t+1<NT;t+=2){
    STEP(pB0,pB1,pA0,pA1,t,(t+3<NT),(t+1<NT),(t+1<NT));       ENDW(t);   RESC(); ROT();
    STEP(pA0,pA1,pB0,pB1,t+1,(t+4<NT),(t+2<NT),(t+2<NT));     ENDW(t+1); RESC(); ROT();
  }
  STEP(pB0,pB1,pA0,pA1,NT-1,false,false,false); RESC();
  { float sacc=pB0[0]+pB0[1]; _Pragma("unroll") for(int r=2;r<16;++r)sacc+=pB0[r]; _Pragma("unroll") for(int r=0;r<16;++r)sacc+=pB1[r]; l_reg+=sacc;
    pw0=(u32x4){PKW(pB0,0),PKW(pB0,2),PKW(pB0,4),PKW(pB0,6)};pw1=(u32x4){PKW(pB0,8),PKW(pB0,10),PKW(pB0,12),PKW(pB0,14)};pw2=(u32x4){PKW(pB1,0),PKW(pB1,2),PKW(pB1,4),PKW(pB1,6)};pw3=(u32x4){PKW(pB1,8),PKW(pB1,10),PKW(pB1,12),PKW(pB1,14)};
    SBAR(); pv(o,vb0+sl_cur,PAF(0),PAF(1),PAF(2),PAF(3)); pv(o+2,vb0+SLOTB+sl_cur,PAF(0),PAF(1),PAF(2),PAF(3)); }
  #undef PKW
  #undef PAF
  #undef VFR
  #undef PIN
  #undef MX3
  #undef GAPA
  #undef GAPB
  #undef EX
  #undef VRD
  #undef KRD
  #undef VRD2
  #undef GAPC
  #undef STEP
  #undef ENDW
  {auto rr=__builtin_amdgcn_permlane32_swap(__float_as_uint(l_reg),__float_as_uint(l_reg),false,false);l_reg=__uint_as_float(rr[0])+__uint_as_float(rr[1]);}
  if(hi==0)wsf[32+r32]=l_reg;asm volatile("s_waitcnt lgkmcnt(0)":::"memory");
  float rli[16];
  #pragma unroll
  for(int r=0;r<16;++r)rli[r]=__builtin_amdgcn_rcpf(wsf[32+crow(r,hi)]);
  { bf16*stg=(bf16*)(shm+LDS_OST)+wid*2048;
    #pragma unroll
    for(int hf=0;hf<2;++hf){
      #pragma unroll
      for(int r=0;r<16;++r){const int orow=crow(r,hi);
        #pragma unroll
        for(int d0=0;d0<2;++d0)stg[orow*64+d0*32+r32]=__float2bfloat16(o[2*hf+d0][r]*rli[r]);}
      asm volatile("s_waitcnt lgkmcnt(0)":::"memory");
      #pragma unroll
      for(int i=0;i<4;++i){const int row=i*8+(lane>>3),ch=lane&7; const u32x4 v=*(const u32x4*)(stg+row*64+ch*8); ATTN_STORE16(const_cast<char*>(uni64(Ow))+(unsigned)(((i*8+(lane>>3))*DM+hf*64+ch*8)*2),v);}
      asm volatile("s_waitcnt lgkmcnt(0)":::"memory"); } }
  asm volatile("s_waitcnt lgkmcnt(0)\n\ts_barrier":::"memory");
  #undef DMA_K
  #undef DMA_V
  #undef TCL
  #undef CMASK
  #undef START
  #undef RESC
  #undef ROT
}
constexpr int ATTN_LDS_BYTES=LDS_BYTES;
#undef SBAR
#undef WAIT_BAR
}
constexpr int NWAVES = 8;
#ifndef MK_ONE_LAUNCH
#define MK_ONE_LAUNCH 1
#endif
constexpr int DMODEL = 1024, DFF = 2816, MP = 65536, MS = 2048, MT = MP + MS;
constexpr int NSTREAM_P = 32, SEQ_P = 2048, NSTREAM_S = 32, SEQ_S = 64, PAST = 4096, KCL = PAST + SEQ_S;
constexpr int NPHASE = 22;
constexpr float LN_EPSF = 1e-5f, RMS_EPSF = 1e-5f;
constexpr float LAM_INIT = 0.35550906759096924f;
constexpr size_t O_Y = 0, O_PSR = (size_t)MT * 1024, O_PSI = O_PSR + 131072, O_PK = O_PSI + 131072, O_PV = O_PK + (size_t)MP * 1024,
                 O_SSR = O_PV + (size_t)MP * 1024, O_SSI = O_SSR + 131072, O_SK = O_SSI + 131072, O_SV = O_SK + (size_t)MS * 1024, O_END = O_SV + (size_t)MS * 1024;
static_assert(O_END == 208142336ull, "output size");
constexpr size_t MiB = 1u << 20;
constexpr size_t WS_CTL = 0, CTL_ZERO_BYTES = 1 * MiB;
constexpr size_t WS_RC = 1 * MiB, WS_RS = 2 * MiB;
constexpr size_t WS_S5 = 3 * MiB;
constexpr size_t WS_WIN = 4 * MiB, WIN_BYTES = 11 * MiB;
constexpr size_t WS_WOUT = 48 * MiB, WOUT_BYTES = 5767168;
constexpr size_t WS_WGLU = 72 * MiB, WS_WQ = 76 * MiB, WS_WKV = 78 * MiB, WS_WO = 82 * MiB;
constexpr size_t WS_XB = 84 * MiB;
constexpr size_t WS_TB = WS_XB + 132 * MiB;
constexpr size_t WS_HB = WS_TB + 132 * MiB;
constexpr size_t WS_ZB = WS_HB, WS_QB = WS_HB, WS_O2 = WS_HB + 132 * MiB;
constexpr size_t WS_KB = WS_HB + 363 * MiB, WS_VB = WS_KB + 128 * MiB;
constexpr size_t WS_KC = WS_VB + 128 * MiB, WS_VC = WS_KC + 260 * MiB;
constexpr size_t WS_END = WS_VC + 260 * MiB;
static_assert(WS_WOUT + 4 * WOUT_BYTES <= WS_WGLU && WS_WIN + 4 * WIN_BYTES <= WS_WOUT, "weight map");
constexpr int CW_TMO = 0, CW_BAR = 4096;
constexpr int RING_BYTES = 133120;
constexpr int LDSCTL_OFF = 135168, MISC_OFF = LDSCTL_OFF + 320, LDS_BYTES = 147456;
static_assert(attn_body::ATTN_LDS_BYTES <= RING_BYTES && pg8::STAGE_BYTES <= RING_BYTES && MISC_OFF + 128 <= LDS_BYTES, "LDS map");

#define GAS __attribute__((address_space(1)))
#define LAS __attribute__((address_space(3)))
typedef unsigned short bf16;
typedef unsigned v4u __attribute__((ext_vector_type(4)));
typedef unsigned v2u __attribute__((ext_vector_type(2)));
typedef float f32x4 __attribute__((ext_vector_type(4)));
typedef GAS unsigned gu32;
#define RLX_AGENT __ATOMIC_RELAXED, __HIP_MEMORY_SCOPE_AGENT
#define LDS_WAIT() asm volatile("s_waitcnt lgkmcnt(0)" ::: "memory")
#define VM_WAIT() asm volatile("s_waitcnt vmcnt(0)" ::: "memory")
__device__ __forceinline__ unsigned f2bf(float f) { unsigned u = __builtin_bit_cast(unsigned, f); return (u + 0x7fffu + ((u >> 16) & 1u)) >> 16; }
__device__ __forceinline__ unsigned pk2(float lo, float hi) { return f2bf(lo) | (f2bf(hi) << 16); }
__device__ __forceinline__ float bflo(unsigned w) { return __uint_as_float(w << 16); }
__device__ __forceinline__ float bfhi(unsigned w) { return __uint_as_float(w & 0xffff0000u); }
__device__ __forceinline__ float wave_sum(float v) {
#pragma unroll
    for (int o = 1; o < 64; o <<= 1) v += __shfl_xor(v, o);
    return v;
}
#define XB_TMO      128
#define XB_XCNT(j)  (256  + 64 * (j))
#define XB_XSUB(j)  (1280 + 64 * (j))
#define XB_XGEN(j)  (2304 + 64 * (j))
#define XB_TOP      3328
#define XB_TOPGEN   3392
#define XCD_BAR_WORDS 3456
#define XB_SPIN_CAP (1u << 18)

__device__ __forceinline__ unsigned xb_ld(unsigned* p)              { return __hip_atomic_load(p, __ATOMIC_RELAXED, __HIP_MEMORY_SCOPE_AGENT); }
__device__ __forceinline__ unsigned xb_add(unsigned* p, unsigned v) { return __hip_atomic_fetch_add(p, v, __ATOMIC_RELAXED, __HIP_MEMORY_SCOPE_AGENT); }
__device__ __forceinline__ unsigned xb_xcc_id() { return (unsigned)__builtin_amdgcn_s_getreg((3 << 11) | 20) & 0xFu; }
#define XB_SPIN(cond, bar) do { unsigned _sp = 0; while (cond) { __builtin_amdgcn_s_sleep(1); \
    if ((++_sp & 255u) == 0u) { if (xb_ld(&(bar)[XB_TMO])) break; if (_sp > XB_SPIN_CAP) { atomicAdd(&(bar)[XB_TMO], 1u); break; } } } } while (0)

struct XcdBarrier {
    unsigned* bar; unsigned x;
    volatile LAS unsigned* st;
};

__device__ __forceinline__ XcdBarrier xcd_barrier_post(unsigned* bar, volatile LAS unsigned* st) {
    XcdBarrier b; b.bar = bar; b.x = xb_xcc_id(); b.st = st;
    if (threadIdx.x == 0) (void)xb_add(&bar[XB_XCNT(b.x)], 1u);
    return b;
}
__device__ __forceinline__ void xcd_barrier_complete(unsigned* bar, unsigned x, unsigned& nloc, unsigned& nx) {
    const unsigned G = gridDim.x * gridDim.y * gridDim.z;
    unsigned sum, cnt, mine, sp = 0u;
    for (;;) {
        sum = 0u; cnt = 0u; mine = 0u;
#pragma unroll
        for (unsigned j = 0; j < 16; ++j) { const unsigned c = xb_ld(&bar[XB_XCNT(j)]); sum += c; cnt += (c > 0u) ? 1u : 0u; mine = (j == x) ? c : mine; }
        if (sum == G) break;
        __builtin_amdgcn_s_sleep(1);
        if ((++sp & 255u) == 0u) { if (xb_ld(&bar[XB_TMO])) break; if (sp > XB_SPIN_CAP) { atomicAdd(&bar[XB_TMO], 1u); break; } }
    }
    nloc = mine > 0u ? mine : 1u; nx = cnt > 0u ? cnt : 1u;
}

__device__ __forceinline__ void xcd_barrier(const XcdBarrier& b) {
    asm volatile("s_waitcnt vmcnt(0)" ::: "memory");
    __syncthreads();
    if (threadIdx.x == 0) {
        unsigned* bar = b.bar;
        __builtin_amdgcn_s_waitcnt(0);
        unsigned nloc = b.st[0], nx = b.st[1];
        if (nloc == 0u) { xcd_barrier_complete(bar, b.x, nloc, nx); b.st[0] = nloc; b.st[1] = nx; }
        const unsigned old = xb_add(&bar[XB_XSUB(b.x)], 1u);
        const unsigned gen = old / nloc;
        if (old + 1u == (gen + 1u) * nloc) {
            __builtin_amdgcn_fence(__ATOMIC_RELEASE, "agent");
            asm volatile("s_waitcnt vmcnt(0)" ::: "memory");
            const unsigned og = xb_add(&bar[XB_TOP], 1u);
            const unsigned tg = og / nx;
            if (og + 1u == (tg + 1u) * nx) xb_add(&bar[XB_TOPGEN], 1u);
            else XB_SPIN(xb_ld(&bar[XB_TOPGEN]) == tg, bar);
            __builtin_amdgcn_fence(__ATOMIC_ACQUIRE, "agent");
            xb_add(&bar[XB_XGEN(b.x)], 1u);
            asm volatile("s_waitcnt vmcnt(0)" ::: "memory");
        } else {
            XB_SPIN(xb_ld(&bar[XB_XGEN(b.x)]) == gen, bar);
            __builtin_amdgcn_fence(__ATOMIC_ACQUIRE, "agent");
            asm volatile("s_waitcnt vmcnt(0)" ::: "memory");
        }
    }
    __syncthreads();
}
__device__ __forceinline__ void dsincos(double x, double& s, double& c) {
    const double k = __builtin_rint(x * 0.63661977236758134308);
    double r = __builtin_fma(-k, 1.57079632679489655800e+00, x); r = __builtin_fma(-k, 6.12323399573676603587e-17, r);
    const double z = r * r;
    double sp = 1.0 / 355687428096000.0;
    sp = __builtin_fma(sp, z, -1.0 / 1307674368000.0); sp = __builtin_fma(sp, z, 1.0 / 6227020800.0); sp = __builtin_fma(sp, z, -1.0 / 39916800.0); sp = __builtin_fma(sp, z, 1.0 / 362880.0);
    sp = __builtin_fma(sp, z, -1.0 / 5040.0); sp = __builtin_fma(sp, z, 1.0 / 120.0); sp = __builtin_fma(sp, z, -1.0 / 6.0); sp = __builtin_fma(sp, z, 1.0);
    const double sr = sp * r;
    double cp = -1.0 / 6402373705728000.0;
    cp = __builtin_fma(cp, z, 1.0 / 20922789888000.0); cp = __builtin_fma(cp, z, -1.0 / 87178291200.0); cp = __builtin_fma(cp, z, 1.0 / 479001600.0); cp = __builtin_fma(cp, z, -1.0 / 3628800.0);
    cp = __builtin_fma(cp, z, 1.0 / 40320.0); cp = __builtin_fma(cp, z, -1.0 / 720.0); cp = __builtin_fma(cp, z, 1.0 / 24.0); cp = __builtin_fma(cp, z, -0.5); cp = __builtin_fma(cp, z, 1.0);
    const int q = (int)((long long)k & 3);
    s = (q == 0) ? sr : (q == 1) ? cp : (q == 2) ? -sr : -cp;
    c = (q == 0) ? cp : (q == 1) ? -sr : (q == 2) ? -cp : sr;
}
__device__ __forceinline__ double dexp(double x) {
    const double n = __builtin_rint(x * 1.44269504088896338700e+00);
    double r = __builtin_fma(-n, 6.93147180369123816490e-01, x); r = __builtin_fma(-n, 1.90821492927058770002e-10, r);
    double p = 1.0 / 6227020800.0;
    p = __builtin_fma(p, r, 1.0 / 479001600.0); p = __builtin_fma(p, r, 1.0 / 39916800.0); p = __builtin_fma(p, r, 1.0 / 3628800.0); p = __builtin_fma(p, r, 1.0 / 362880.0); p = __builtin_fma(p, r, 1.0 / 40320.0);
    p = __builtin_fma(p, r, 1.0 / 5040.0); p = __builtin_fma(p, r, 1.0 / 720.0); p = __builtin_fma(p, r, 1.0 / 120.0); p = __builtin_fma(p, r, 1.0 / 24.0); p = __builtin_fma(p, r, 1.0 / 6.0);
    p = __builtin_fma(p, r, 0.5); p = __builtin_fma(p, r, 1.0); p = __builtin_fma(p, r, 1.0);
    const long long bits = ((long long)n + 1023ll) << 52;
    return p * __builtin_bit_cast(double, bits);
}

__device__ __forceinline__ int map_col(int mode, int j) {
    const int pn = j >> 8, bj = (j >> 7) & 1, jj = j & 127;
    if (mode == 1) return bj * 2816 + 128 * pn + jj;
    if (mode == 2) return bj * 1024 + 128 * pn + jj;
    if (mode == 3 || (mode == 4 && pn < 4)) return 64 * (4 * pn + (jj >> 5)) + 32 * bj + (jj & 31);
    return j;
}
__device__ __forceinline__ void p0_transpose_item(const float* W, int K, int ldw, int N, int mode, bf16* WT, LAS float* scr, int item, int lane) {
    const int nblk = N / 32, kb = item / nblk, nb = item % nblk, k0 = 64 * kb, n0 = 32 * nb, s0 = map_col(mode, n0);
#pragma unroll 8
    for (int i = 0; i < 32; ++i) { const int kk = 2 * i + (lane >> 5); scr[kk * 33 + (lane & 31)] = W[(size_t)(k0 + kk) * ldw + s0 + (lane & 31)]; }
    LDS_WAIT(); asm volatile("" ::: "memory");
    const int c = lane & 7;
#pragma unroll
    for (int j = 0; j < 4; ++j) { const int n = (lane >> 3) + 8 * j; const LAS float* s = scr + (8 * c) * 33 + n;
        v4u o; o.x = pk2(s[0 * 33], s[1 * 33]); o.y = pk2(s[2 * 33], s[3 * 33]); o.z = pk2(s[4 * 33], s[5 * 33]); o.w = pk2(s[6 * 33], s[7 * 33]);
        *(GAS v4u*)(WT + (size_t)(n0 + n) * K + k0 + 8 * c) = o; }
    LDS_WAIT(); asm volatile("" ::: "memory");
}
__device__ __forceinline__ void cvt_stream(const float* src, bf16* dst, size_t n8, size_t blk, size_t gap, size_t gt, size_t ngt) {
    for (size_t i = gt; i < n8; i += ngt) {
        const size_t e = i * 8; const f32x4 a = *(const GAS f32x4*)(src + e), b = *(const GAS f32x4*)(src + e + 4);
        v4u o; o.x = pk2(a.x, a.y); o.y = pk2(a.z, a.w); o.z = pk2(b.x, b.y); o.w = pk2(b.z, b.w);
        *(GAS v4u*)(dst + e + (gap ? (e / blk) * gap : 0)) = o;
    }
}
__device__ __forceinline__ void cache_cvt_part(const float* ck, const float* cv, unsigned char* ws, size_t lo, size_t hi, size_t thr, size_t nthr) {
    constexpr size_t N8 = (size_t)NSTREAM_S * PAST * 1024 / 8, BLK = (size_t)PAST * 1024, GAP = (size_t)SEQ_S * 1024;
    for (size_t i = lo + thr; i < hi; i += nthr) {
        const bool isv = i >= N8; const size_t e = (isv ? i - N8 : i) * 8; const float* src = (isv ? cv : ck) + e;
        const f32x4 a = __builtin_nontemporal_load((const GAS f32x4*)src), b = __builtin_nontemporal_load((const GAS f32x4*)(src + 4));
        v4u o; o.x = pk2(a.x, a.y); o.y = pk2(a.z, a.w); o.z = pk2(b.x, b.y); o.w = pk2(b.z, b.w);
        *(GAS v4u*)((bf16*)(ws + (isv ? WS_VC : WS_KC)) + e + (e / BLK) * GAP) = o;
    }
}
struct P0Args { const float *xp, *xs, *ck, *cv, *win, *wout, *wglu, *wq, *wkv, *wo, *a_re, *a_im, *log_dt, *b_re, *b_im; unsigned char* ws; };
__device__ __forceinline__ void p0_prologue(const P0Args& A, LAS unsigned char* lds, int vcu, int G, int wave, int lane) {
    LAS float* scr = (LAS float*)(lds + wave * 16384);
    const int gw = vcu * NWAVES + wave, NGW = G * NWAVES;
    unsigned char* ws = A.ws;
    constexpr int I_IN = 16 * 176, I_OUT = 44 * 32, I_GLU = 16 * 64, I_Q = 16 * 32, I_KV = 16 * 64, I_O = 16 * 32;
    constexpr int NITEMS = 4 * I_IN + 4 * I_OUT + I_GLU + I_Q + I_KV + I_O;
    for (int it = gw; it < NITEMS; it += NGW) {
        int r = it;
        if (r < 4 * I_IN) { const int w = r / I_IN; p0_transpose_item(A.win + (size_t)w * 1024 * 5632, 1024, 5632, 5632, 1, (bf16*)(ws + WS_WIN + w * WIN_BYTES), scr, r % I_IN, lane); continue; } r -= 4 * I_IN;
        if (r < 4 * I_OUT) { const int w = r / I_OUT; p0_transpose_item(A.wout + (size_t)w * 2816 * 1024, 2816, 1024, 1024, 0, (bf16*)(ws + WS_WOUT + w * WOUT_BYTES), scr, r % I_OUT, lane); continue; } r -= 4 * I_OUT;
        if (r < I_GLU) { p0_transpose_item(A.wglu, 1024, 2048, 2048, 2, (bf16*)(ws + WS_WGLU), scr, r, lane); continue; } r -= I_GLU;
        if (r < I_Q) { p0_transpose_item(A.wq, 1024, 1024, 1024, 3, (bf16*)(ws + WS_WQ), scr, r, lane); continue; } r -= I_Q;
        if (r < I_KV) { p0_transpose_item(A.wkv, 1024, 2048, 2048, 4, (bf16*)(ws + WS_WKV), scr, r, lane); continue; } r -= I_KV;
        p0_transpose_item(A.wo, 1024, 1024, 1024, 0, (bf16*)(ws + WS_WO), scr, r, lane);
    }
    const size_t gt = (size_t)gw * 64 + lane, ngt = (size_t)NGW * 64;
    for (size_t it = gt; it < (size_t)KCL * 32; it += ngt) {
        const int pos = (int)(it >> 5), i = (int)(it & 31);
        double th = 1.0; for (int k = 0; k < i; ++k) th *= 0.74989420933245582730;
        double s, c; dsincos((double)pos * th, s, c);
        ((float*)(ws + WS_RC))[it] = (float)c; ((float*)(ws + WS_RS))[it] = (float)s;
    }
    for (size_t it = gt; it < 4096; it += ngt) {
        const int g = (int)(it >> 6);
        const double lre = fmin((double)A.a_re[it], -1e-4), lim = (double)A.a_im[it], dt = dexp((double)A.log_dt[g]);
        const double mag = dexp(lre * dt); double sn, cs; dsincos(fabs(lim * dt), sn, cs); if (lim < 0.0) sn = -sn;
        const double lbr = mag * cs, lbi = mag * sn, den = lre * lre + lim * lim, nre = lbr - 1.0;
        const double cre = (nre * lre + lbi * lim) / den, cim = (lbi * lre - nre * lim) / den;
        float* lb = (float*)(ws + WS_S5); lb[2 * it] = (float)lbr; lb[2 * it + 1] = (float)lbi;
        float* bb = (float*)(ws + WS_S5) + 8192 + it * 32;
        for (int c = 0; c < 16; ++c) { const double br = A.b_re[it * 16 + c], bi = A.b_im[it * 16 + c]; bb[c] = (float)(cre * br - cim * bi); bb[16 + c] = (float)(cre * bi + cim * br); }
    }
    cvt_stream(A.xp, (bf16*)(ws + WS_XB), (size_t)MP * 1024 / 8, 1, 0, gt, ngt);
    cvt_stream(A.xs, (bf16*)(ws + WS_XB) + (size_t)MP * 1024, (size_t)MS * 1024 / 8, 1, 0, gt, ngt);
}

__device__ __forceinline__ void ln_phase(const bf16* T, const float* g, const float* b, bf16* Xo, float* Yo, int gw, int NGW, int lane) {
    constexpr int RB = 4;
    float gv[16], bv[16];
#pragma unroll
    for (int j = 0; j < 2; ++j)
#pragma unroll
        for (int i = 0; i < 8; ++i) { gv[8 * j + i] = g[512 * j + 8 * lane + i]; bv[8 * j + i] = b[512 * j + 8 * lane + i]; }
    for (int rbase = gw * RB; rbase < MT; rbase += NGW * RB) {
        v4u t0[RB], t1[RB];
#pragma unroll
        for (int k = 0; k < RB; ++k) { const int row = (rbase + k < MT) ? rbase + k : MT - 1; const bf16* tp = T + (size_t)row * 1024 + 8 * lane; t0[k] = *(const GAS v4u*)tp; t1[k] = *(const GAS v4u*)(tp + 512); }
#pragma unroll
        for (int k = 0; k < RB; ++k) {
            const int row = rbase + k; if (row >= MT) break;
            float v[16];
            v[0] = bflo(t0[k].x); v[1] = bfhi(t0[k].x); v[2] = bflo(t0[k].y); v[3] = bfhi(t0[k].y); v[4] = bflo(t0[k].z); v[5] = bfhi(t0[k].z); v[6] = bflo(t0[k].w); v[7] = bfhi(t0[k].w);
            v[8] = bflo(t1[k].x); v[9] = bfhi(t1[k].x); v[10] = bflo(t1[k].y); v[11] = bfhi(t1[k].y); v[12] = bflo(t1[k].z); v[13] = bfhi(t1[k].z); v[14] = bflo(t1[k].w); v[15] = bfhi(t1[k].w);
            float s = 0.f;
#pragma unroll
            for (int i = 0; i < 16; ++i) s += v[i];
            const float mean = wave_sum(s) * (1.f / 1024.f); float s2 = 0.f;
#pragma unroll
            for (int i = 0; i < 16; ++i) { v[i] -= mean; s2 += v[i] * v[i]; }
            const float rstd = 1.f / sqrtf(wave_sum(s2) * (1.f / 1024.f) + LN_EPSF);
#pragma unroll
            for (int i = 0; i < 16; ++i) v[i] = v[i] * rstd * gv[i] + bv[i];
            if (Yo) {
                float* yp = Yo + (size_t)row * 1024 + 8 * lane;
                *(GAS f32x4*)yp = (f32x4){v[0], v[1], v[2], v[3]}; *(GAS f32x4*)(yp + 4) = (f32x4){v[4], v[5], v[6], v[7]};
                *(GAS f32x4*)(yp + 512) = (f32x4){v[8], v[9], v[10], v[11]}; *(GAS f32x4*)(yp + 516) = (f32x4){v[12], v[13], v[14], v[15]};
            } else {
                bf16* xp = Xo + (size_t)row * 1024 + 8 * lane;
                v4u o; o.x = pk2(v[0], v[1]); o.y = pk2(v[2], v[3]); o.z = pk2(v[4], v[5]); o.w = pk2(v[6], v[7]); *(GAS v4u*)xp = o;
                o.x = pk2(v[8], v[9]); o.y = pk2(v[10], v[11]); o.z = pk2(v[12], v[13]); o.w = pk2(v[14], v[15]); *(GAS v4u*)(xp + 512) = o;
            }
        }
    }
}

__device__ __forceinline__ void combine_phase(bf16* O1, const bf16* O2, const float* lamv, const float* subg, int gw, int NGW, int lane) {
    constexpr int RB = 4;
    const float lam = expf(wave_sum(lamv[lane] * lamv[64 + lane])) - expf(wave_sum(lamv[128 + lane] * lamv[192 + lane])) + LAM_INIT;
    float gs[16];
#pragma unroll
    for (int i = 0; i < 16; ++i) gs[i] = subg[(lane & 7) * 16 + i] * (1.f - LAM_INIT);
    for (int rbase = gw * RB; rbase < MT; rbase += NGW * RB) {
        v4u a0[RB], a1[RB], b0[RB], b1[RB];
#pragma unroll
        for (int k = 0; k < RB; ++k) { const int row = (rbase + k < MT) ? rbase + k : MT - 1; const bf16* p1 = O1 + (size_t)row * 1024 + 16 * lane; const bf16* p2 = O2 + (size_t)row * 1024 + 16 * lane;
            a0[k] = *(const GAS v4u*)p1; a1[k] = *(const GAS v4u*)(p1 + 8); b0[k] = *(const GAS v4u*)p2; b1[k] = *(const GAS v4u*)(p2 + 8); }
#pragma unroll
        for (int k = 0; k < RB; ++k) {
            const int row = rbase + k; if (row >= MT) break;
            float v[16];
            v[0] = bflo(a0[k].x) - lam * bflo(b0[k].x); v[1] = bfhi(a0[k].x) - lam * bfhi(b0[k].x); v[2] = bflo(a0[k].y) - lam * bflo(b0[k].y); v[3] = bfhi(a0[k].y) - lam * bfhi(b0[k].y);
            v[4] = bflo(a0[k].z) - lam * bflo(b0[k].z); v[5] = bfhi(a0[k].z) - lam * bfhi(b0[k].z); v[6] = bflo(a0[k].w) - lam * bflo(b0[k].w); v[7] = bfhi(a0[k].w) - lam * bfhi(b0[k].w);
            v[8] = bflo(a1[k].x) - lam * bflo(b1[k].x); v[9] = bfhi(a1[k].x) - lam * bfhi(b1[k].x); v[10] = bflo(a1[k].y) - lam * bflo(b1[k].y); v[11] = bfhi(a1[k].y) - lam * bfhi(b1[k].y);
            v[12] = bflo(a1[k].z) - lam * bflo(b1[k].z); v[13] = bfhi(a1[k].z) - lam * bfhi(b1[k].z); v[14] = bflo(a1[k].w) - lam * bflo(b1[k].w); v[15] = bfhi(a1[k].w) - lam * bfhi(b1[k].w);
            float ss = 0.f;
#pragma unroll
            for (int i = 0; i < 16; ++i) ss += v[i] * v[i];
            ss += __shfl_xor(ss, 1); ss += __shfl_xor(ss, 2); ss += __shfl_xor(ss, 4);
            const float r = 1.f / sqrtf(ss * (1.f / 128.f) + RMS_EPSF);
#pragma unroll
            for (int i = 0; i < 16; ++i) v[i] = v[i] * r * gs[i];
            bf16* p1 = O1 + (size_t)row * 1024 + 16 * lane;
            v4u o; o.x = pk2(v[0], v[1]); o.y = pk2(v[2], v[3]); o.z = pk2(v[4], v[5]); o.w = pk2(v[6], v[7]); *(GAS v4u*)p1 = o;
            o.x = pk2(v[8], v[9]); o.y = pk2(v[10], v[11]); o.z = pk2(v[12], v[13]); o.w = pk2(v[14], v[15]); *(GAS v4u*)(p1 + 8) = o;
        }
    }
}

__device__ __forceinline__ float gelu_tanh(float x) { const float t = 1.5957691216057308f * (x + 0.044715f * x * x * x); return x * __builtin_amdgcn_rcpf(1.f + __builtin_amdgcn_exp2f(-1.4426950408889634f * t)); }
struct S5Args { const bf16* XB; bf16* ZB; const float* s5p; const float *c_re, *c_im, *dsk, *st_re, *st_im; float* out; };
__device__ __forceinline__ void s5_valu_phase(const S5Args& A, LAS float* ybuf, int gw, int NGW, int lane) {
    for (int pass = 0; pass < 2; ++pass)
    for (int wu = gw; wu < 2048; wu += NGW) {
        const int stream = wu >> 6, g = wu & 63, nch = pass == 0 ? 32 : 1, gp = g * 64 + lane;
        const size_t row0 = pass == 0 ? (size_t)stream * 2048 : (size_t)MP + (size_t)stream * 64;
        const float lbr = A.s5p[2 * gp], lbi = A.s5p[2 * gp + 1];
        float bbr[16], bbi[16], cr[16], ci[16], dk[16];
#pragma unroll
        for (int c = 0; c < 16; ++c) { bbr[c] = A.s5p[8192 + gp * 32 + c]; bbi[c] = A.s5p[8192 + gp * 32 + 16 + c]; cr[c] = A.c_re[(g * 16 + c) * 64 + lane]; ci[c] = A.c_im[(g * 16 + c) * 64 + lane]; dk[c] = A.dsk[g * 16 + c]; }
        float hr = 0.f, hi = 0.f;
        if (pass == 1) { hr = A.st_re[(stream * 64 + g) * 64 + lane]; hi = A.st_im[(stream * 64 + g) * 64 + lane]; }
        const bf16* xp = A.XB + (row0 + lane) * 1024 + g * 16;
        v4u w0 = *(const GAS v4u*)xp, w1 = *(const GAS v4u*)(xp + 8);
        for (int ch = 0; ch < nch; ++ch) {
            v4u n0 = w0, n1 = w1;
            if (ch + 1 < nch) { n0 = *(const GAS v4u*)(xp + (size_t)(ch + 1) * 65536); n1 = *(const GAS v4u*)(xp + (size_t)(ch + 1) * 65536 + 8); }
#pragma unroll 2
            for (int t = 0; t < 64; ++t) {
                unsigned sw[8];
                sw[0] = __builtin_amdgcn_readlane(w0.x, t); sw[1] = __builtin_amdgcn_readlane(w0.y, t); sw[2] = __builtin_amdgcn_readlane(w0.z, t); sw[3] = __builtin_amdgcn_readlane(w0.w, t);
                sw[4] = __builtin_amdgcn_readlane(w1.x, t); sw[5] = __builtin_amdgcn_readlane(w1.y, t); sw[6] = __builtin_amdgcn_readlane(w1.z, t); sw[7] = __builtin_amdgcn_readlane(w1.w, t);
                float bur = 0.f, bui = 0.f;
#pragma unroll
                for (int k = 0; k < 8; ++k) { const float u0 = bflo(sw[k]), u1 = bfhi(sw[k]); bur += bbr[2 * k] * u0; bui += bbi[2 * k] * u0; bur += bbr[2 * k + 1] * u1; bui += bbi[2 * k + 1] * u1; }
                const float nr = lbr * hr - lbi * hi + bur, ni = lbr * hi + lbi * hr + bui; hr = nr; hi = ni;
                float v[16];
#pragma unroll
                for (int c = 0; c < 16; ++c) v[c] = cr[c] * hr - ci[c] * hi;
                float v8[8], v4[4], v2[2];
#pragma unroll
                for (int i = 0; i < 8; ++i) { const bool up = lane >= 32; const float keep = up ? v[i + 8] : v[i], send = up ? v[i] : v[i + 8]; v8[i] = keep + __shfl_xor(send, 32); }
#pragma unroll
                for (int i = 0; i < 4; ++i) { const bool up = (lane & 16) != 0; const float keep = up ? v8[i + 4] : v8[i], send = up ? v8[i] : v8[i + 4]; v4[i] = keep + __shfl_xor(send, 16); }
#pragma unroll
                for (int i = 0; i < 2; ++i) { const bool up = (lane & 8) != 0; const float keep = up ? v4[i + 2] : v4[i], send = up ? v4[i] : v4[i + 2]; v2[i] = keep + __shfl_xor(send, 8); }
                float y; { const bool up = (lane & 4) != 0; const float keep = up ? v2[1] : v2[0], send = up ? v2[0] : v2[1]; y = keep + __shfl_xor(send, 4); }
                y += __shfl_xor(y, 2); y += __shfl_xor(y, 1);
                if ((lane & 3) == 0) ybuf[t * 17 + (lane >> 2)] = y;
            }
            LDS_WAIT(); asm volatile("" ::: "memory");
            {
                float z[16];
                const unsigned ww[8] = {w0.x, w0.y, w0.z, w0.w, w1.x, w1.y, w1.z, w1.w};
#pragma unroll
                for (int k = 0; k < 8; ++k) { z[2 * k] = gelu_tanh(ybuf[lane * 17 + 2 * k] + dk[2 * k] * bflo(ww[k])); z[2 * k + 1] = gelu_tanh(ybuf[lane * 17 + 2 * k + 1] + dk[2 * k + 1] * bfhi(ww[k])); }
                bf16* zp = A.ZB + (row0 + (size_t)ch * 64 + lane) * 1024 + g * 16;
                v4u o; o.x = pk2(z[0], z[1]); o.y = pk2(z[2], z[3]); o.z = pk2(z[4], z[5]); o.w = pk2(z[6], z[7]); *(GAS v4u*)zp = o;
                o.x = pk2(z[8], z[9]); o.y = pk2(z[10], z[11]); o.z = pk2(z[12], z[13]); o.w = pk2(z[14], z[15]); *(GAS v4u*)(zp + 8) = o;
            }
            LDS_WAIT(); asm volatile("" ::: "memory");
            w0 = n0; w1 = n1;
        }
        float* ore = A.out + (pass == 0 ? O_PSR : O_SSR) + (size_t)(stream * 64 + g) * 64 + lane;
        ore[0] = hr; ore[131072] = hi;
    }
}
typedef short s5_bf16x8 __attribute__((ext_vector_type(8)));
typedef float s5_f32x16 __attribute__((ext_vector_type(16)));
__device__ __forceinline__ int s5_crow(int r, int hi) { return (r & 3) + 8 * (r >> 2) + 4 * hi; }
constexpr int S5_RS = 272, S5_WAVE_LDS = 32 * S5_RS;
__device__ __forceinline__ void s5_mfma_phase(const S5Args& A, LAS unsigned char* hs, int gw, int NGW, int lane) {
    const int p32 = lane & 31, hi = lane >> 5;
    for (int pass = 0; pass < 2; ++pass)
    for (int wu = gw; wu < 2048; wu += NGW) {
        const int stream = wu >> 6, g = wu & 63, nsub = pass == 0 ? 64 : 2;
        const size_t row0 = pass == 0 ? (size_t)stream * 2048 : (size_t)MP + (size_t)stream * 64;
        s5_bf16x8 bre[2], bim[2]; float L[2][4][2]; float h[2][2];
#pragma unroll
        for (int pb = 0; pb < 2; ++pb) {
            const int gp = g * 64 + 32 * pb + p32; const float* bb = A.s5p + 8192 + gp * 32;
#pragma unroll
            for (int k = 0; k < 8; ++k) { const int c = 4 * hi + (k & 3) + 8 * (k >> 2); bre[pb][k] = (short)f2bf(bb[c]); bim[pb][k] = (short)f2bf(bb[16 + c]); }
            const float lr = A.s5p[2 * gp], li = A.s5p[2 * gp + 1];
            L[pb][0][0] = lr; L[pb][0][1] = li;
            L[pb][1][0] = lr * lr - li * li; L[pb][1][1] = 2.f * lr * li;
            L[pb][2][0] = L[pb][1][0] * lr - L[pb][1][1] * li; L[pb][2][1] = L[pb][1][0] * li + L[pb][1][1] * lr;
            L[pb][3][0] = L[pb][1][0] * L[pb][1][0] - L[pb][1][1] * L[pb][1][1]; L[pb][3][1] = 2.f * L[pb][1][0] * L[pb][1][1];
            h[pb][0] = 0.f; h[pb][1] = 0.f;
            if (pass == 1) { h[pb][0] = A.st_re[(stream * 64 + g) * 64 + 32 * pb + p32]; h[pb][1] = A.st_im[(stream * 64 + g) * 64 + 32 * pb + p32]; }
        }
        s5_bf16x8 cm[8];
#pragma unroll
        for (int kb = 0; kb < 8; ++kb)
#pragma unroll
            for (int k = 0; k < 8; ++k) { const int p = 8 * kb + 4 * hi + (k >> 1); const int ci = (g * 16 + (p32 & 15)) * 64 + p;
                const float v = (k & 1) ? -A.c_im[ci] : A.c_re[ci]; cm[kb][k] = (short)(p32 < 16 ? f2bf(v) : 0u); }
        float dk[8];
#pragma unroll
        for (int j = 0; j < 4; ++j) { dk[j] = A.dsk[g * 16 + 4 * hi + j]; dk[4 + j] = A.dsk[g * 16 + 8 + 4 * hi + j]; }
        const bf16* up = A.XB + (row0 + p32) * 1024 + g * 16 + 4 * hi;
        v2u u0 = *(const GAS v2u*)up, u1 = *(const GAS v2u*)(up + 8);
        LAS unsigned* hw = (LAS unsigned*)(hs + hi * 4 * S5_RS + 4 * p32);
        const LAS unsigned char* hr = hs + p32 * S5_RS + 16 * hi;
        for (int sc = 0; sc < nsub; ++sc) {
            v2u n0 = u0, n1 = u1;
            if (sc + 1 < nsub) { n0 = *(const GAS v2u*)(up + (size_t)(sc + 1) * 32768); n1 = *(const GAS v2u*)(up + (size_t)(sc + 1) * 32768 + 8); }
            const v4u uw = {u0.x, u0.y, u1.x, u1.y};
            const s5_bf16x8 ua = __builtin_bit_cast(s5_bf16x8, uw);
            s5_f32x16 xr[2], xi[2];
            const s5_f32x16 z16 = {};
#pragma unroll
            for (int pb = 0; pb < 2; ++pb) { xr[pb] = __builtin_amdgcn_mfma_f32_32x32x16_bf16(ua, bre[pb], z16, 0, 0, 0); xi[pb] = __builtin_amdgcn_mfma_f32_32x32x16_bf16(ua, bim[pb], z16, 0, 0, 0); }
#pragma unroll
            for (int pb = 0; pb < 2; ++pb) {
                const float l1r = L[pb][0][0], l1i = L[pb][0][1], l4r = L[pb][3][0], l4i = L[pb][3][1];
#pragma unroll
                for (int q = 0; q < 4; ++q)
#pragma unroll
                    for (int i = 1; i < 4; ++i) { const float pr = xr[pb][4 * q + i - 1], pi = xi[pb][4 * q + i - 1];
                        xr[pb][4 * q + i] += l1r * pr - l1i * pi; xi[pb][4 * q + i] += l1r * pi + l1i * pr; }
                float cr[9], ci[9]; cr[0] = h[pb][0]; ci[0] = h[pb][1];
#pragma unroll
                for (int q = 0; q < 4; ++q) {
                    const float er = xr[pb][4 * q + 3], ei = xi[pb][4 * q + 3];
                    const auto sr = __builtin_amdgcn_permlane32_swap(__float_as_uint(er), __float_as_uint(er), false, false);
                    const auto si = __builtin_amdgcn_permlane32_swap(__float_as_uint(ei), __float_as_uint(ei), false, false);
                    const float e0r = __uint_as_float(sr[0]), e1r = __uint_as_float(sr[1]), e0i = __uint_as_float(si[0]), e1i = __uint_as_float(si[1]);
                    cr[2 * q + 1] = l4r * cr[2 * q] - l4i * ci[2 * q] + e0r; ci[2 * q + 1] = l4r * ci[2 * q] + l4i * cr[2 * q] + e0i;
                    cr[2 * q + 2] = l4r * cr[2 * q + 1] - l4i * ci[2 * q + 1] + e1r; ci[2 * q + 2] = l4r * ci[2 * q + 1] + l4i * cr[2 * q + 1] + e1i;
                }
                h[pb][0] = cr[8]; h[pb][1] = ci[8];
#pragma unroll
                for (int q = 0; q < 4; ++q) { const float mr = hi ? cr[2 * q + 1] : cr[2 * q], mi = hi ? ci[2 * q + 1] : ci[2 * q];
#pragma unroll
                    for (int i = 0; i < 4; ++i) { xr[pb][4 * q + i] += L[pb][i][0] * mr - L[pb][i][1] * mi; xi[pb][4 * q + i] += L[pb][i][0] * mi + L[pb][i][1] * mr; } }
#pragma unroll
                for (int r = 0; r < 16; ++r) hw[((r & 3) + 8 * (r >> 2)) * (S5_RS / 4) + 32 * pb] = pk2(xr[pb][r], xi[pb][r]);
            }
            s5_f32x16 yt = {};
#pragma unroll
            for (int kb = 0; kb < 8; ++kb) { const s5_bf16x8 hf = *(const LAS s5_bf16x8*)(hr + 32 * kb); yt = __builtin_amdgcn_mfma_f32_32x32x16_bf16(cm[kb], hf, yt, 0, 0, 0); }
            {
                float z[8];
                z[0] = gelu_tanh(yt[0] + dk[0] * bflo(u0.x)); z[1] = gelu_tanh(yt[1] + dk[1] * bfhi(u0.x)); z[2] = gelu_tanh(yt[2] + dk[2] * bflo(u0.y)); z[3] = gelu_tanh(yt[3] + dk[3] * bfhi(u0.y));
                z[4] = gelu_tanh(yt[4] + dk[4] * bflo(u1.x)); z[5] = gelu_tanh(yt[5] + dk[5] * bfhi(u1.x)); z[6] = gelu_tanh(yt[6] + dk[6] * bflo(u1.y)); z[7] = gelu_tanh(yt[7] + dk[7] * bfhi(u1.y));
                bf16* zp = A.ZB + (row0 + (size_t)sc * 32 + p32) * 1024 + g * 16 + 4 * hi;
                v2u o; o.x = pk2(z[0], z[1]); o.y = pk2(z[2], z[3]); *(GAS v2u*)zp = o;
                o.x = pk2(z[4], z[5]); o.y = pk2(z[6], z[7]); *(GAS v2u*)(zp + 8) = o;
            }
            u0 = n0; u1 = n1;
        }
        if (hi == 0) {
            float* ore = A.out + (pass == 0 ? O_PSR : O_SSR) + (size_t)(stream * 64 + g) * 64 + p32;
            ore[0] = h[0][0]; ore[32] = h[1][0]; ore[131072] = h[0][1]; ore[131072 + 32] = h[1][1];
        }
    }
}
__device__ __forceinline__ void attention_phase(char* lds, const bf16* QB, const bf16* KB, const bf16* VB, const bf16* KC, const bf16* VC, bf16* O1, bf16* O2, int vcu, int G) {
    typedef attn_body::bf16 abf;
    const int wid = __builtin_amdgcn_readfirstlane((int)(threadIdx.x >> 6)), wm = wid >> 2, wv = (wid >> 1) & 1, qh = wid & 1;
    const int ngrp = G / 32;
    const int qb = wid & 3;
    for (int grp = vcu / 32; grp < 8; grp += ngrp) {
        const int c = vcu % 32, ch = c >> 1;
        for (int s = 0; s < 17; ++s) {
            const bool smp = (s == ch);
            if (smp) {
                const int bh = grp * 32 + c, b = bh >> 3, h = bh & 7;
                const size_t qrow = (size_t)MP + (size_t)b * SEQ_S + 32 * qh;
                attn_body::attn_unit<8>((const abf*)(QB + qrow * 1024 + h * 128 + wm * 64), (const abf*)(KC + (size_t)b * KCL * 1024 + h * 128), (const abf*)(VC + (size_t)b * KCL * 1024 + h * 128),
                                        (abf*)((wm ? O2 : O1) + qrow * 1024 + h * 128 + wv * 64), KCL / 64, lds);
            } else {
                const int k = s - (s > ch ? 1 : 0), bh = grp * 32 + 2 * k + (c & 1), b = bh >> 3, h = bh & 7, jj = (k & 1) ? 15 - ch : ch;
                const size_t qrow = (size_t)b * SEQ_P + 128 * jj + 32 * qb;
                attn_body::attn_unit2<8>((const abf*)(QB + qrow * 1024 + h * 128 + wm * 64), (const abf*)(KB + (size_t)b * SEQ_P * 1024 + h * 128), (const abf*)(VB + (size_t)b * SEQ_P * 1024 + h * 128),
                                         (abf*)((wm ? O2 : O1) + qrow * 1024 + h * 128), 2 * jj + 2, 2 * jj + 1 + (qb >> 1), lds);
            }
        }
    }
}

struct Args { const float* in[24]; float* out; unsigned char* ws; int ph_lo, ph_hi, li, pad; };
__global__ void __launch_bounds__(NWAVES * 64, 2) yoco_fwd(Args args) {
    extern __shared__ __attribute__((aligned(16))) unsigned char lds[];
    LAS unsigned char* const L = (LAS unsigned char*)lds;
    volatile LAS unsigned* MISC = (volatile LAS unsigned*)(L + MISC_OFF);
    const int tid = threadIdx.x, lane = tid & 63, wave = __builtin_amdgcn_readfirstlane(tid >> 6);
    const int G = gridDim.x; const int bx = blockIdx.x; const int vcu = (G % 8 == 0) ? (bx % 8) * (G / 8) + bx / 8 : bx;
    const int gw = vcu * NWAVES + wave, NGW = G * NWAVES;
    unsigned char* ws = args.ws;
    gu32* ctl = (gu32*)(ws + WS_CTL);
    for (int u = tid; u < (LDS_BYTES - LDSCTL_OFF) / 4; u += NWAVES * 64) ((LAS unsigned*)(L + LDSCTL_OFF))[u] = 0u;
    __syncthreads();
    XcdBarrier bar; bar.bar = (unsigned*)(ctl + CW_BAR); bar.x = 0; bar.st = nullptr;
#if MK_ONE_LAUNCH
    bar = xcd_barrier_post((unsigned*)(ctl + CW_BAR), MISC + 8);
#endif
    const int lo = args.ph_lo, hi = args.ph_hi;
#ifndef PHMASK
#define PHMASK 0xffffffffu
#endif
#define IN(k) (((PHMASK >> (k)) & 1u) && lo <= (k) && (k) < hi)
#define SEAM(k) do { if (IN(k) && IN((k) + 1)) xcd_barrier(bar); } while (0)
    const float *x_prompt = args.in[0], *x_sample = args.in[1], *cache_k = args.in[2], *cache_v = args.in[3], *st_re = args.in[4], *st_im = args.in[5], *ln_g = args.in[6], *ln_b = args.in[7],
                *ffn_w_in = args.in[8], *ffn_w_out = args.in[9], *a_re = args.in[10], *a_im = args.in[11], *log_dt = args.in[12], *b_re = args.in[13], *b_im = args.in[14], *c_re = args.in[15],
                *c_im = args.in[16], *ssm_d = args.in[17], *w_glu = args.in[18], *w_q = args.in[19], *w_kv = args.in[20], *attn_lam = args.in[21], *subln_g = args.in[22], *w_o = args.in[23];
    float* out = args.out;
    bf16* XB = (bf16*)(ws + WS_XB); bf16* TB = (bf16*)(ws + WS_TB); bf16* HB = (bf16*)(ws + WS_HB); bf16* ZB = (bf16*)(ws + WS_ZB); bf16* QB = (bf16*)(ws + WS_QB); bf16* O2 = (bf16*)(ws + WS_O2);
    bf16* KB = (bf16*)(ws + WS_KB); bf16* VB = (bf16*)(ws + WS_VB); bf16* KC = (bf16*)(ws + WS_KC); bf16* VC = (bf16*)(ws + WS_VC);
    const float* RC = (const float*)(ws + WS_RC); const float* RS = (const float*)(ws + WS_RS);
#define WIN(i) ((const bf16*)(ws + WS_WIN + (size_t)(i) * WIN_BYTES))
#define WOUT(i) ((const bf16*)(ws + WS_WOUT + (size_t)(i) * WOUT_BYTES))
#define FFN_UP(i) do { pg8::Gemm g{XB, WIN(i), MT, 2 * DFF, DMODEL}; pg8::StaticOrder S; S.init(MT, 2 * DFF, G, bx); pg8::EpiSwiglu E{HB, DFF}; \
        pg8::gemm_phase<pg8::EpiSwiglu, pg8::StaticOrder, true, true>(L, g, S, E); } while (0)
#define FFN_DOWN(i) do { pg8::Gemm g{HB, WOUT(i), MT, DMODEL, DFF}; pg8::StaticOrder S; S.init(MT, DMODEL, G, bx); pg8::EpiResid E{XB, TB, 0.5f}; \
        pg8::gemm_phase<pg8::EpiResid, pg8::StaticOrder, true, true>(L, g, S, E); } while (0)
    constexpr size_t CC_N = 2 * (size_t)NSTREAM_S * PAST * 1024 / 8;
#define CACHE_PART(f0, f1) CACHE_PART_N(1056, f0, f1)
#define CACHE_PART_N(nwg, f0, f1) do { const int ntail = (nwg) % G; if (bx >= ntail && G > ntail) cache_cvt_part(cache_k, cache_v, ws, (size_t)(CC_N * (f0)), (size_t)(CC_N * (f1)), (size_t)(bx - ntail) * 512 + tid, (size_t)(G - ntail) * 512); } while (0)
#define LNORM(i, Yo) ln_phase(TB, ln_g + (i) * 1024, ln_b + (i) * 1024, XB, (Yo), gw, NGW, lane)

    if (IN(0)) { P0Args A{x_prompt, x_sample, cache_k, cache_v, ffn_w_in, ffn_w_out, w_glu, w_q, w_kv, w_o, a_re, a_im, log_dt, b_re, b_im, ws}; p0_prologue(A, L, vcu, G, wave, lane);
#if defined(PROBE_PRO2)
        __syncthreads(); p0_prologue(A, L, vcu, G, wave, lane);
#endif
    } SEAM(0);
    if (IN(1)) { FFN_UP(0);
#if defined(PROBE_UP2)
        FFN_UP(0);
#endif
    } SEAM(1);
    if (IN(2)) { FFN_DOWN(0); CACHE_PART(0.0, 0.27);
#if defined(PROBE_DOWN2)
        FFN_DOWN(0);
#endif
    } SEAM(2);
    if (IN(3)) { LNORM(0, nullptr);
#if defined(PROBE_LN2)
        LNORM(0, nullptr);
#endif
    } SEAM(3);
    if (IN(4)) { S5Args A{XB, ZB, (const float*)(ws + WS_S5), c_re, c_im, ssm_d, st_re, st_im, out};
#if defined(S5_VALU)
                 s5_valu_phase(A, (LAS float*)(L + wave * 4352), gw, NGW, lane);
#else
                 s5_mfma_phase(A, L + wave * S5_WAVE_LDS, gw, NGW, lane);
#endif
#if defined(PROBE_S52)
                 s5_mfma_phase(A, L + wave * S5_WAVE_LDS, gw, NGW, lane);
#endif
 } SEAM(4);
    if (IN(5)) { pg8::Gemm g{ZB, (const bf16*)(ws + WS_WGLU), MT, 2048, DMODEL}; pg8::StaticOrder S; S.init(MT, 2048, G, bx); pg8::EpiGlu E{XB, TB};
                 pg8::gemm_phase<pg8::EpiGlu, pg8::StaticOrder, true, true>(L, g, S, E); CACHE_PART_N(2112, 0.27, 0.36); } SEAM(5);
    if (IN(6)) { LNORM(1, nullptr); } SEAM(6);
    if (IN(7)) { FFN_UP(1); } SEAM(7);
    if (IN(8)) { FFN_DOWN(1); CACHE_PART(0.36, 0.63); } SEAM(8);
    if (IN(9)) { LNORM(2, nullptr); } SEAM(9);
    if (IN(10)) { pg8::Gemm g{XB, (const bf16*)(ws + WS_WKV), MT, 2048, DMODEL}; pg8::StaticOrder S; S.init(MT, 2048, G, G - 1 - bx);
                  pg8::EpiKV E{KB, VB, KC, VC, out + O_PK, out + O_PV, out + O_SK, out + O_SV, RC, RS};
                  pg8::gemm_phase<pg8::EpiKV, pg8::StaticOrder, true, true>(L, g, S, E); }
    if (IN(10)) { FFN_UP(2); } SEAM(11);
    if (IN(12)) { FFN_DOWN(2); CACHE_PART(0.63, 0.90); } SEAM(12);
    if (IN(13)) { LNORM(3, nullptr); } SEAM(13);
    if (IN(14)) { pg8::Gemm g{XB, (const bf16*)(ws + WS_WQ), MT, DMODEL, DMODEL}; pg8::StaticOrder S; S.init(MT, DMODEL, G, bx); pg8::EpiQ E{QB, RC, RS, attn_body::C2};
                  pg8::gemm_phase<pg8::EpiQ, pg8::StaticOrder, true, true>(L, g, S, E); CACHE_PART(0.90, 1.0); } SEAM(14);
    if (IN(15)) {
#if defined(PROBE_ATTN2)
        attention_phase((char*)lds, QB, KB, VB, KC, VC, TB, TB, vcu, G);
#endif
        attention_phase((char*)lds, QB, KB, VB, KC, VC, QB, O2, vcu, G); } SEAM(15);
    if (IN(16)) { combine_phase(QB, O2, attn_lam, subln_g, gw, NGW, lane); } SEAM(16);
    if (IN(17)) { pg8::Gemm g{QB, (const bf16*)(ws + WS_WO), MT, DMODEL, DMODEL}; pg8::StaticOrder S; S.init(MT, DMODEL, G, bx); pg8::EpiResid E{XB, TB, 1.0f};
                  pg8::gemm_phase<pg8::EpiResid, pg8::StaticOrder, true, true>(L, g, S, E); } SEAM(17);
    if (IN(18)) { LNORM(4, nullptr); } SEAM(18);
    if (IN(19)) { FFN_UP(3); } SEAM(19);
    if (IN(20)) { FFN_DOWN(3); } SEAM(20);
    if (IN(21)) { LNORM(5, out + O_Y); }
#undef IN
#undef SEAM
}

extern "C" void kernel_launch(void* const* d_in, const int* in_sizes, int n_in, void* d_out, int out_size, void* d_ws, size_t ws_size, hipStream_t stream) {
    static int grid = 0;
    if (grid == 0) {
        if (n_in != 24 || (size_t)out_size != O_END || ws_size < WS_END) { fprintf(stderr, "kernel_launch: unexpected problem shape (n_in %d, out %d, ws %zu < %zu); nothing launched\n", n_in, out_size, ws_size, (size_t)WS_END); grid = -1; return; }
        int dev = 0, cus = 0, per_cu = 0;
        if (hipGetDevice(&dev) != hipSuccess || hipDeviceGetAttribute(&cus, hipDeviceAttributeMultiprocessorCount, dev) != hipSuccess) { grid = -1; return; }
        if (hipFuncSetAttribute((const void*)yoco_fwd, hipFuncAttributeMaxDynamicSharedMemorySize, LDS_BYTES) != hipSuccess) { fprintf(stderr, "kernel_launch: hipFuncSetAttribute failed\n"); grid = -1; return; }
        if (hipOccupancyMaxActiveBlocksPerMultiprocessor(&per_cu, (const void*)yoco_fwd, NWAVES * 64, LDS_BYTES) != hipSuccess || per_cu < 1) { fprintf(stderr, "kernel_launch: occupancy query reports %d blocks per CU\n", per_cu); }
        (void)hipGetLastError();
        grid = (cus / 32) * 32; if (grid < 32) grid = 32;
    }
    if (grid < 0) return;
    if (hipMemsetAsync((char*)d_ws + WS_CTL, 0, CTL_ZERO_BYTES, stream) != hipSuccess) return;
    Args a{};
    for (int i = 0; i < 24; ++i) a.in[i] = (const float*)d_in[i];
    a.out = (float*)d_out; a.ws = (unsigned char*)d_ws; a.pad = 0;
#if MK_ONE_LAUNCH
    a.ph_lo = 0; a.ph_hi = NPHASE; a.li = 0;
    hipLaunchKernelGGL(yoco_fwd, dim3(grid), dim3(NWAVES * 64), LDS_BYTES, stream, a);
#else
    for (int p = 0; p < NPHASE; ++p) { a.ph_lo = p; a.ph_hi = p + 1; a.li = p; hipLaunchKernelGGL(yoco_fwd, dim3(grid), dim3(NWAVES * 64), LDS_BYTES, stream, a); }
#endif
}
```
